# Optimizing an MI355X kernel written in HIP

```python
import jax, jax.numpy as jnp
from jax import lax
import numpy as np

D_MODEL = 1024
BATCH = 8
SEQ = 2048
DEPTH = 1

ATT_HEADS = 8
ATT_KV_HEADS = 2
HEAD_DIM = 64
ATT_WIDTH = ATT_HEADS * HEAD_DIM
KV_WIDTH = ATT_KV_HEADS * HEAD_DIM
IDX_HEADS = 8
IDX_DIM = 64
TOPK_MAX = 256
Q_BLOCK = 128
ROPE_THETA = 500000.0
ROPE_FRACTION = 4
HG_HEADS = 4
HG_KDIM = 128
HG_VDIM = 128
HG_FWIDTH = HG_HEADS * HG_KDIM
HG_WIDTH = HG_HEADS * HG_VDIM
CHUNK = 64
MIX_WIDTH = ATT_WIDTH + HG_WIDTH
D_FF = ((-(-8 * D_MODEL // 3) + 255) // 256) * 256
NORM_EPS = 1e-6
IN_SPLITS = (ATT_WIDTH, KV_WIDTH, KV_WIDTH, IDX_HEADS * IDX_DIM, IDX_DIM, IDX_HEADS,
             HG_FWIDTH, HG_FWIDTH, HG_WIDTH, HG_WIDTH)
IN_WIDTH = sum(IN_SPLITS)

kernel_name = "hymba_dsa_hgrn2_sandwich_layer"


def rms_norm(x, gain):
    x32 = x.astype(jnp.float32)
    y = x32 * lax.rsqrt(jnp.mean(x32 * x32, axis=-1, keepdims=True) + NORM_EPS)
    return (y * gain.astype(jnp.float32)).astype(x.dtype)


def partial_rope(x, pos):
    d = x.shape[-1]
    rd = d // ROPE_FRACTION
    half = rd // 2
    inv = ROPE_THETA ** (-jnp.arange(half, dtype=jnp.float32) / half)
    ang = pos.astype(jnp.float32)[:, None] * inv[None, :]
    ang = ang.reshape((ang.shape[0],) + (1,) * (x.ndim - 3) + (half,))
    cos = jnp.cos(ang).astype(x.dtype)
    sin = jnp.sin(ang).astype(x.dtype)
    x1 = x[..., :half]
    x2 = x[..., half:rd]
    return jnp.concatenate([x1 * cos - x2 * sin, x2 * cos + x1 * sin, x[..., rd:]], axis=-1)


def split_columns(p):
    pts = []
    acc = 0
    for s in IN_SPLITS[:-1]:
        acc += s
        pts.append(acc)
    return jnp.split(p, pts, axis=-1)


def dsa_attention(q, k, v, qi, ki, wi):
    B, T = q.shape[0], q.shape[1]
    S = k.shape[1]
    topk = min(TOPK_MAX, S // 4)
    nb = T // Q_BLOCK
    key_pos = jnp.arange(S)
    group = ATT_HEADS // ATT_KV_HEADS

    def to_blocks(a):
        return jnp.swapaxes(a.reshape((B, nb, Q_BLOCK) + a.shape[2:]), 0, 1)

    qpos = jnp.arange(T).reshape(nb, Q_BLOCK)

    def block(args):
        qb, qib, wib, tpos = args
        rel = jax.nn.relu(jnp.einsum('bthd,bsd->btsh', qib, ki))
        iscore = jnp.einsum('btsh,bth->bts', rel, wib).astype(jnp.float32)
        causal = key_pos[None, :] <= tpos[:, None]
        iscore = jnp.where(causal[None], iscore, -jnp.inf)
        _, idx = lax.top_k(iscore, topk)
        valid = idx <= tpos[None, :, None]
        ksel = jax.vmap(lambda kk, ii: kk[ii])(k, idx)
        vsel = jax.vmap(lambda vv, ii: vv[ii])(v, idx)
        qg = qb.reshape(B, Q_BLOCK, ATT_KV_HEADS, group, HEAD_DIM)
        s = jnp.einsum('btgrd,btkgd->btgrk', qg, ksel).astype(jnp.float32) * (HEAD_DIM ** -0.5)
        s = jnp.where(valid[:, :, None, None, :], s, -jnp.inf)
        p = jax.nn.softmax(s, axis=-1).astype(v.dtype)
        o = jnp.einsum('btgrk,btkgd->btgrd', p, vsel)
        return o.reshape(B, Q_BLOCK, ATT_WIDTH)

    out = lax.map(block, (to_blocks(q), to_blocks(qi), to_blocks(wi), qpos))
    return jnp.swapaxes(out, 0, 1).reshape(B, T, ATT_WIDTH)


def hgrn2_chunkwise(q, k, v, logf):
    B, T, H, K = q.shape
    V = v.shape[-1]
    nc = T // CHUNK

    def chunks(a):
        return jnp.moveaxis(a.reshape(B, nc, CHUNK, H, a.shape[-1]), 1, 0)

    tri = jnp.tril(jnp.ones((CHUNK, CHUNK), dtype=bool))

    def step(state, inp):
        qc, kc, vc, gc = inp
        b = jnp.cumsum(gc, axis=1)
        o_inter = jnp.einsum('bthk,bhkv->bthv', qc * jnp.exp(b), state)
        diff = b[:, :, None] - b[:, None, :]
        decay = jnp.exp(jnp.where(tri[None, :, :, None, None], diff, -jnp.inf))
        a = jnp.einsum('bthk,bshk,btshk->bhts', qc, kc, decay)
        o_intra = jnp.einsum('bhts,bshv->bthv', a, vc)
        b_last = b[:, -1]
        new_state = jnp.exp(b_last)[..., None] * state + jnp.einsum(
            'bshk,bshv->bhkv', kc * jnp.exp(b_last[:, None] - b), vc)
        return new_state, o_inter + o_intra

    s0 = jnp.zeros((B, H, K, V), jnp.float32)
    _, o = lax.scan(step, s0, (chunks(q), chunks(k), chunks(v), chunks(logf)))
    return jnp.moveaxis(o, 0, 1).reshape(B, T, H, V)


def hgrn2_mixer(hq, hf, hi, hg, lb_param, out_gain, layer):
    B, T = hq.shape[0], hq.shape[1]
    lb = jnp.cumsum(jax.nn.softmax(lb_param.astype(jnp.float32), axis=0), axis=0)[layer]
    f = lb + (1.0 - lb) * jax.nn.sigmoid(hf.astype(jnp.float32))
    logf = jnp.log(f).reshape(B, T, HG_HEADS, HG_KDIM)
    k = (1.0 - f).reshape(B, T, HG_HEADS, HG_KDIM)
    q = jax.nn.silu(hq.astype(jnp.float32)).reshape(B, T, HG_HEADS, HG_KDIM)
    v = hi.astype(jnp.float32).reshape(B, T, HG_HEADS, HG_VDIM)
    o = hgrn2_chunkwise(q, k, v, logf)
    o = rms_norm(o, out_gain.reshape(HG_HEADS, HG_VDIM))
    o = o.reshape(B, T, HG_WIDTH) * jax.nn.silu(hg.astype(jnp.float32))
    return o.astype(hq.dtype)


def setup_inputs(seed: int = 0) -> dict:
    key = jax.random.key(seed)
    ks = jax.random.split(key, 13)
    f32 = jnp.float32

    def w(k, shape, fan_in):
        return jax.random.normal(k, shape, f32) * (fan_in ** -0.5)

    def gain(k, shape):
        return 1.0 + 0.02 * jax.random.normal(k, shape, f32)

    return {
        "x": jax.random.normal(ks[0], (BATCH, SEQ, D_MODEL), f32),
        "norm_pre_mix": gain(ks[1], (DEPTH, D_MODEL)),
        "w_in": w(ks[2], (DEPTH, D_MODEL, IN_WIDTH), D_MODEL),
        "w_out": w(ks[3], (DEPTH, MIX_WIDTH, D_MODEL), MIX_WIDTH),
        "norm_post_mix": gain(ks[4], (DEPTH, D_MODEL)),
        "hg_lower_bound": jax.random.normal(ks[5], (DEPTH + 1, HG_FWIDTH), f32),
        "hg_out_norm": gain(ks[6], (DEPTH, HG_WIDTH)),
        "norm_pre_ffn": gain(ks[7], (DEPTH, D_MODEL)),
        "w_gate": w(ks[8], (DEPTH, D_MODEL, D_FF), D_MODEL),
        "w_up": w(ks[9], (DEPTH, D_MODEL, D_FF), D_MODEL),
        "w_down": w(ks[10], (DEPTH, D_FF, D_MODEL), D_FF),
        "norm_post_ffn": gain(ks[11], (DEPTH, D_MODEL)),
    }


def reference(x, norm_pre_mix, w_in, w_out, norm_post_mix, hg_lower_bound, hg_out_norm,
              norm_pre_ffn, w_gate, w_up, w_down, norm_post_ffn):
    B, T, _ = x.shape
    pos = jnp.arange(T)
    idx_scale = (IDX_HEADS ** -0.5) * (IDX_DIM ** -0.5)
    for l in range(DEPTH):
        h = rms_norm(x, norm_pre_mix[l])
        proj = jnp.einsum('btd,de->bte', h, w_in[l])
        q, k, v, qi, ki, wi, hq, hf, hi, hg = split_columns(proj)
        q = partial_rope(q.reshape(B, T, ATT_HEADS, HEAD_DIM), pos)
        k = partial_rope(k.reshape(B, T, ATT_KV_HEADS, HEAD_DIM), pos)
        v = v.reshape(B, T, ATT_KV_HEADS, HEAD_DIM)
        qi = partial_rope(qi.reshape(B, T, IDX_HEADS, IDX_DIM), pos)
        ki = partial_rope(ki, pos)
        wi = wi * idx_scale
        att_out = dsa_attention(q, k, v, qi, ki, wi)
        hg_out = hgrn2_mixer(hq, hf, hi, hg, hg_lower_bound, hg_out_norm[l], l)
        mix = jnp.einsum('bte,ed->btd', jnp.concatenate([att_out, hg_out], axis=-1), w_out[l])
        x = x + rms_norm(mix, norm_post_mix[l])
        h2 = rms_norm(x, norm_pre_ffn[l])
        ff = jax.nn.silu(jnp.einsum('btd,df->btf', h2, w_gate[l])) * jnp.einsum('btd,df->btf', h2, w_up[l])
        ff = jnp.einsum('btf,fd->btd', ff, w_down[l])
        x = x + rms_norm(ff, norm_post_ffn[l])
    return x
```

```cpp
#include <hip/hip_runtime.h>
#include <cstdint>
#include <cstdio>

typedef unsigned short bf16_t;
constexpr int BATCH = 8, SEQ = 2048, DM = 1024, M = BATCH * SEQ;
constexpr int NIN = 3400, NINP = 3584, DFF = 2816;
constexpr float C2 = 0.125f * 1.4426950408889634f;
constexpr float IDX_SCALE = 0.04419417382415922f;
constexpr float EPS = 1e-6f;

__host__ __device__ inline int w1_src_col(int n) {
    if (n < 1280) return n;
    if (n < 3328) return 1352 + (n - 1280);
    if (n < 3392) return 1280 + (n - 3328);
    if (n < 3400) return 1344 + (n - 3392);
    return -1;
}

constexpr size_t MiB = 1u << 20;
constexpr size_t WS_CTL = 0, WS_TAB = 1 * MiB, WS_W1 = 2 * MiB, WS_WO = 9 * MiB, WS_WGU = 11 * MiB, WS_WD = 22 * MiB;
constexpr size_t WS_XN = 28 * MiB;
constexpr size_t WS_CAT = 60 * MiB;
constexpr size_t WS_K = 92 * MiB, WS_V = 96 * MiB, WS_QI = 100 * MiB, WS_KI = 116 * MiB, WS_WI = 118 * MiB, WS_G = 119 * MiB;
constexpr size_t WS_HV = 120 * MiB, WS_HG = 136 * MiB, WS_MASK = 152 * MiB, WS_TMP = 160 * MiB;
constexpr size_t WS_FF = 60 * MiB;
constexpr size_t WS_END = 224 * MiB;

__device__ __host__ inline bf16_t f2bf(float f) { unsigned u = __builtin_bit_cast(unsigned, f); return (bf16_t)((u + 0x7fffu + ((u >> 16) & 1u)) >> 16); }
__device__ __host__ inline float bf2f(bf16_t h) { return __builtin_bit_cast(float, (unsigned)h << 16); }
__device__ inline float silu_f(float x) { return x / (1.f + __expf(-x)); }
__device__ inline float sigmoid_f(float x) { return 1.f / (1.f + __expf(-x)); }

template <int NT> __device__ inline float block_sum(float v, float* red) {
#pragma unroll
    for (int o = 32; o > 0; o >>= 1) v += __shfl_xor(v, o);
    __syncthreads();
    if ((threadIdx.x & 63) == 0) red[threadIdx.x >> 6] = v;
    __syncthreads();
    float s = 0.f;
#pragma unroll
    for (int i = 0; i < NT / 64; ++i) s += red[i];
    return s;
}
template <int NT> __device__ inline float block_max(float v, float* red) {
#pragma unroll
    for (int o = 32; o > 0; o >>= 1) v = fmaxf(v, __shfl_xor(v, o));
    __syncthreads();
    if ((threadIdx.x & 63) == 0) red[threadIdx.x >> 6] = v;
    __syncthreads();
    float s = red[0];
#pragma unroll
    for (int i = 1; i < NT / 64; ++i) s = fmaxf(s, red[i]);
    return s;
}

__device__ inline void sincos_taylor(double r, double& s, double& c) {
    const double r2 = r * r; double ts = r, tc = 1.0; s = r; c = 1.0;
#pragma unroll
    for (int k = 1; k <= 14; ++k) { tc = -tc * r2 / (double)((2 * k - 1) * (2 * k)); ts = -ts * r2 / (double)((2 * k) * (2 * k + 1)); c += tc; s += ts; }
}
__global__ void nk_tables(float* rope, float* lb, const float* lbp) {
    const int i = blockIdx.x * blockDim.x + threadIdx.x;
    if (i < 2048 * 8) {
        const int pos = i >> 3, j = i & 7;
        const float inv = powf(500000.0f, -(float)j / 8.0f);
        const float ang = (float)pos * inv;
        const double a = (double)ang, twopi = 6.283185307179586476925;
        const double n = rint(a / twopi), r = a - n * twopi;
        double s, c; sincos_taylor(r, s, c);
        rope[2 * i] = (float)c; rope[2 * i + 1] = (float)s;
    }
    if (i < 512) { const float a = lbp[i], b = lbp[512 + i]; const float m = fmaxf(a, b); const float ea = expf(a - m), eb = expf(b - m); lb[i] = ea / (ea + eb); }
}

__global__ void nk_convert(const float* s0, const float* s1, bf16_t* dst, int N, int K, int mode) {
    const size_t idx = blockIdx.x * (size_t)blockDim.x + threadIdx.x; if (idx >= (size_t)N * K) return;
    const int n = (int)(idx % N), k = (int)(idx / N);
    const float* s = s0; int c = n, ncols = N;
    if (mode == 0) { c = w1_src_col(n); ncols = NIN; }
    else if (mode == 2) { const int t = n >> 8, w = n & 255; if (w < 128) c = t * 128 + w; else { s = s1; c = t * 128 + w - 128; } ncols = DFF; }
    const float v = (c >= 0) ? s[(size_t)k * ncols + c] : 0.f;
    dst[(size_t)n * K + k] = f2bf(v);
}

__global__ void __launch_bounds__(256) nk_rmsnorm_bf16(const float* x, const float* g, bf16_t* out) {
    __shared__ float red[8];
    const int row = blockIdx.x, tid = threadIdx.x;
    const float4 v = ((const float4*)(x + (size_t)row * DM))[tid];
    const float ss = block_sum<256>(v.x * v.x + v.y * v.y + v.z * v.z + v.w * v.w, red);
    const float r = rsqrtf(ss * (1.f / DM) + EPS);
    const float4 gg = ((const float4*)g)[tid];
    bf16_t* o = out + (size_t)row * DM + tid * 4;
    o[0] = f2bf(v.x * r * gg.x); o[1] = f2bf(v.y * r * gg.y); o[2] = f2bf(v.z * r * gg.z); o[3] = f2bf(v.w * r * gg.w);
}

struct EpiRawF32 { float* C; int ldc; __device__ void operator()(int r, int c, float v, float) const { C[(size_t)r * ldc + c] = v; } };
struct EpiSwiglu { bf16_t* FF; __device__ void operator()(int r, int c, float g, float u) const { FF[(size_t)r * DFF + c] = f2bf(silu_f(g) * u); } };
template <int DUAL, class Epi>
__global__ void __launch_bounds__(256) nk_gemm(const bf16_t* A, const bf16_t* Bt, int K, Epi epi) {
    __shared__ float As[16][68], Bs[16][68], Bs2[16][68];
    const int tid = threadIdx.x, tx = tid & 15, ty = tid >> 4;
    const int m0 = blockIdx.y * 64, n0 = blockIdx.x * 64;
    const int bn0 = DUAL ? ((n0 >> 7) * 256 + (n0 & 127)) : n0;
    float acc[4][4], acc2[4][4];
#pragma unroll
    for (int i = 0; i < 4; ++i)
#pragma unroll
        for (int j = 0; j < 4; ++j) { acc[i][j] = 0.f; acc2[i][j] = 0.f; }
    const int lr = tid >> 2, lk = (tid & 3) * 4;
    for (int k0 = 0; k0 < K; k0 += 16) {
        { const ushort4 va = *(const ushort4*)(A + (size_t)(m0 + lr) * K + k0 + lk);
          As[lk][lr] = bf2f(va.x); As[lk + 1][lr] = bf2f(va.y); As[lk + 2][lr] = bf2f(va.z); As[lk + 3][lr] = bf2f(va.w);
          const ushort4 vb = *(const ushort4*)(Bt + (size_t)(bn0 + lr) * K + k0 + lk);
          Bs[lk][lr] = bf2f(vb.x); Bs[lk + 1][lr] = bf2f(vb.y); Bs[lk + 2][lr] = bf2f(vb.z); Bs[lk + 3][lr] = bf2f(vb.w);
          if (DUAL) { const ushort4 vc = *(const ushort4*)(Bt + (size_t)(bn0 + 128 + lr) * K + k0 + lk);
              Bs2[lk][lr] = bf2f(vc.x); Bs2[lk + 1][lr] = bf2f(vc.y); Bs2[lk + 2][lr] = bf2f(vc.z); Bs2[lk + 3][lr] = bf2f(vc.w); } }
        __syncthreads();
#pragma unroll
        for (int kk = 0; kk < 16; ++kk) {
            float a[4], b[4], b2[4];
#pragma unroll
            for (int i = 0; i < 4; ++i) { a[i] = As[kk][ty * 4 + i]; b[i] = Bs[kk][tx * 4 + i]; b2[i] = DUAL ? Bs2[kk][tx * 4 + i] : 0.f; }
#pragma unroll
            for (int i = 0; i < 4; ++i)
#pragma unroll
                for (int j = 0; j < 4; ++j) { acc[i][j] += a[i] * b[j]; if (DUAL) acc2[i][j] += a[i] * b2[j]; }
        }
        __syncthreads();
    }
#pragma unroll
    for (int i = 0; i < 4; ++i)
#pragma unroll
        for (int j = 0; j < 4; ++j) epi(m0 + ty * 4 + i, n0 + tx * 4 + j, acc[i][j], acc2[i][j]);
}

struct G1Out { bf16_t* CAT; bf16_t* K; bf16_t* V; bf16_t* QI; bf16_t* KI; float* WI; float* LOGF; bf16_t* HV; bf16_t* HG; const float* rope; const float* lb; };
__global__ void nk_g1_transform(const float* TMP, int c0, int ncols, G1Out o) {
    const size_t idx = blockIdx.x * (size_t)blockDim.x + threadIdx.x; if (idx >= (size_t)M * ncols) return;
    const int lc = (int)(idx % ncols), row = (int)(idx / ncols), pc = c0 + lc, pos = row & (SEQ - 1);
    const float val = TMP[(size_t)row * 1024 + lc];
    auto roped = [&](int d) -> float {
        if (d >= 16) return val;
        const int j = d & 7; const float cs = o.rope[(pos * 8 + j) * 2], sn = o.rope[(pos * 8 + j) * 2 + 1];
        if (d < 8) { const float v2 = TMP[(size_t)row * 1024 + lc + 8]; return val * cs - v2 * sn; }
        const float v1 = TMP[(size_t)row * 1024 + lc - 8]; return val * cs + v1 * sn;
    };
    if (pc < 512) { o.CAT[(size_t)row * 1024 + pc] = f2bf(roped(pc & 63) * C2); }
    else if (pc < 640) { o.K[(size_t)row * 128 + pc - 512] = f2bf(roped((pc - 512) & 63)); }
    else if (pc < 768) { o.V[(size_t)row * 128 + pc - 640] = f2bf(val); }
    else if (pc < 1280) { o.QI[(size_t)row * 512 + pc - 768] = f2bf(roped((pc - 768) & 63)); }
    else if (pc < 1792) { o.CAT[(size_t)row * 1024 + 512 + pc - 1280] = f2bf(silu_f(val)); }
    else if (pc < 2304) { const int j = pc - 1792; const float l = o.lb[j]; const float f = l + (1.f - l) * sigmoid_f(val); o.LOGF[(size_t)row * 512 + j] = logf(f); }
    else if (pc < 2816) { o.HV[(size_t)row * 512 + pc - 2304] = f2bf(val); }
    else if (pc < 3328) { o.HG[(size_t)row * 512 + pc - 2816] = f2bf(silu_f(val)); }
    else if (pc < 3392) { o.KI[(size_t)row * 64 + pc - 3328] = f2bf(roped(pc - 3328)); }
    else if (pc < 3400) { o.WI[(size_t)row * 8 + pc - 3392] = val * IDX_SCALE; }
}

__device__ inline unsigned fkey(float x) { const unsigned u = __float_as_uint(x); return (u & 0x80000000u) ? ~u : (u | 0x80000000u); }
__global__ void __launch_bounds__(256) nk_indexer(const bf16_t* QI, const bf16_t* KI, const float* WI, unsigned* MASK) {
    __shared__ float qs[512]; __shared__ float wsh[8]; __shared__ unsigned keys[2048]; __shared__ float red[8];
    const int row = blockIdx.x, b = row >> 11, t = row & 2047, tid = threadIdx.x;
    for (int i = tid; i < 512; i += 256) qs[i] = bf2f(QI[(size_t)row * 512 + i]);
    if (tid < 8) wsh[tid] = WI[(size_t)row * 8 + tid];
    __syncthreads();
    for (int s = tid; s < 2048; s += 256) {
        unsigned key = 0u;
        if (s <= t) {
            const bf16_t* kr = KI + (size_t)(b * 2048 + s) * 64;
            float dot[8];
#pragma unroll
            for (int h = 0; h < 8; ++h) dot[h] = 0.f;
#pragma unroll 4
            for (int d = 0; d < 64; ++d) { const float kd = bf2f(kr[d]);
#pragma unroll
                for (int h = 0; h < 8; ++h) dot[h] += qs[h * 64 + d] * kd; }
            float sc = 0.f;
#pragma unroll
            for (int h = 0; h < 8; ++h) sc += wsh[h] * fmaxf(dot[h], 0.f);
            if (sc == 0.f) sc = 0.f;
            key = fkey(sc);
        }
        keys[s] = key;
    }
    __syncthreads();
    unsigned T = 1u;
    if (t + 1 > 256) {
        T = 0u;
        for (int bit = 31; bit >= 0; --bit) {
            const unsigned cand = T | (1u << bit); int c = 0;
            for (int s = tid; s < 2048; s += 256) c += (keys[s] >= cand) ? 1 : 0;
            const int tot = (int)block_sum<256>((float)c, red);
            if (tot >= 256) T = cand;
        }
        int c = 0;
        for (int s = tid; s < 2048; s += 256) c += (keys[s] > T) ? 1 : 0;
        const int cgt = (int)block_sum<256>((float)c, red);
        c = 0;
        for (int s = tid; s < 2048; s += 256) c += (keys[s] >= T) ? 1 : 0;
        const int cge = (int)block_sum<256>((float)c, red);
        if (cge != 256) {
            __syncthreads();
            if (tid == 0) { int need = 256 - cgt; for (int s = 0; s < 2048; ++s) if (keys[s] == T) { if (need > 0) --need; else keys[s] = 0u; } }
            __syncthreads();
        }
    }
    if (tid < 64) { unsigned w = 0u; for (int j = 0; j < 32; ++j) if (keys[32 * tid + j] >= T) w |= (1u << j); MASK[(size_t)row * 64 + tid] = w; }
}

__global__ void __launch_bounds__(256) nk_attention(bf16_t* CAT, const bf16_t* Kb, const bf16_t* Vb, const unsigned* MASK) {
    __shared__ int idx[256]; __shared__ float p[8][256]; __shared__ float qs[512]; __shared__ float red[8]; __shared__ int Lsh;
    const int row = blockIdx.x, b = row >> 11, tid = threadIdx.x;
    for (int i = tid; i < 512; i += 256) qs[i] = bf2f(CAT[(size_t)row * 1024 + i]);
    if (tid < 64) {
        unsigned w = MASK[(size_t)row * 64 + tid]; const int c = __popc(w); int inc = c;
#pragma unroll
        for (int o = 1; o < 64; o <<= 1) { const int v = __shfl_up(inc, o); if (tid >= o) inc += v; }
        int pos = inc - c;
        while (w) { const int j = __ffs(w) - 1; if (pos < 256) idx[pos] = 32 * tid + j; ++pos; w &= w - 1; }
        if (tid == 63) Lsh = inc < 256 ? inc : 256;
    }
    __syncthreads();
    const int L = Lsh; const bool act = tid < L; const int s = act ? idx[tid] : 0;
    float sc[8];
#pragma unroll
    for (int g = 0; g < 2; ++g) {
        const bf16_t* kr = Kb + (size_t)(b * 2048 + s) * 128 + g * 64;
        float d4[4] = {0.f, 0.f, 0.f, 0.f};
#pragma unroll 4
        for (int d = 0; d < 64; ++d) { const float kd = bf2f(kr[d]);
#pragma unroll
            for (int hh = 0; hh < 4; ++hh) d4[hh] += qs[(4 * g + hh) * 64 + d] * kd; }
#pragma unroll
        for (int hh = 0; hh < 4; ++hh) sc[4 * g + hh] = d4[hh];
    }
#pragma unroll
    for (int h = 0; h < 8; ++h) {
        const float m = block_max<256>(act ? sc[h] : -INFINITY, red);
        const float e = act ? exp2f(sc[h] - m) : 0.f;
        const float sum = block_sum<256>(e, red);
        p[h][tid] = e / sum;
    }
    __syncthreads();
#pragma unroll
    for (int rep = 0; rep < 2; ++rep) {
        const int oi = tid + 256 * rep, h = oi >> 6, d = oi & 63; float acc = 0.f;
#pragma unroll 4
        for (int j = 0; j < L; ++j) acc += p[h][j] * bf2f(Vb[(size_t)(b * 2048 + idx[j]) * 128 + (h >> 2) * 64 + d]);
        CAT[(size_t)row * 1024 + oi] = f2bf(acc);
    }
}

__global__ void __launch_bounds__(512) nk_hgrn_scan(const bf16_t* CAT, const float* LOGF, const bf16_t* HV, float* O) {
    __shared__ float qf[128], ff[128], vv[128], part[4][128];
    const int b = blockIdx.x >> 2, h = blockIdx.x & 3, tid = threadIdx.x, v = tid & 127, kq = tid >> 7;
    float S[32];
#pragma unroll
    for (int i = 0; i < 32; ++i) S[i] = 0.f;
    for (int t = 0; t < SEQ; ++t) {
        const size_t row = (size_t)b * SEQ + t;
        if (tid < 128) { qf[tid] = bf2f(CAT[row * 1024 + 512 + h * 128 + tid]); ff[tid] = expf(LOGF[row * 512 + h * 128 + tid]); vv[tid] = bf2f(HV[row * 512 + h * 128 + tid]); }
        __syncthreads();
        const float vval = vv[v]; float po = 0.f;
#pragma unroll
        for (int i = 0; i < 32; ++i) { const int k = kq * 32 + i; const float f = ff[k]; S[i] = f * S[i] + (1.f - f) * vval; po += S[i] * qf[k]; }
        part[kq][v] = po;
        __syncthreads();
        if (tid < 128) O[row * 512 + h * 128 + tid] = (part[0][tid] + part[1][tid]) + (part[2][tid] + part[3][tid]);
    }
}
__global__ void __launch_bounds__(128) nk_hgrn_out(const float* O, const bf16_t* HG, const float* gain, bf16_t* CAT) {
    __shared__ float red[8];
    const int row = blockIdx.x >> 2, h = blockIdx.x & 3, tid = threadIdx.x;
    const float o = O[(size_t)row * 512 + h * 128 + tid];
    const float ss = block_sum<128>(o * o, red);
    const float r = rsqrtf(ss * (1.f / 128.f) + EPS);
    CAT[(size_t)row * 1024 + 512 + h * 128 + tid] = f2bf(o * r * gain[h * 128 + tid] * bf2f(HG[(size_t)row * 512 + h * 128 + tid]));
}

__global__ void __launch_bounds__(256) nk_post_mix(const float* mix, const float* x, const float* g1, const float* g2, float* out, bf16_t* H2) {
    __shared__ float red[8];
    const int row = blockIdx.x, tid = threadIdx.x;
    const float4 m = ((const float4*)(mix + (size_t)row * DM))[tid];
    const float r1 = rsqrtf(block_sum<256>(m.x * m.x + m.y * m.y + m.z * m.z + m.w * m.w, red) * (1.f / DM) + EPS);
    const float4 xv = ((const float4*)(x + (size_t)row * DM))[tid], a = ((const float4*)g1)[tid], c = ((const float4*)g2)[tid];
    float4 x1; x1.x = xv.x + m.x * r1 * a.x; x1.y = xv.y + m.y * r1 * a.y; x1.z = xv.z + m.z * r1 * a.z; x1.w = xv.w + m.w * r1 * a.w;
    ((float4*)(out + (size_t)row * DM))[tid] = x1;
    const float r2 = rsqrtf(block_sum<256>(x1.x * x1.x + x1.y * x1.y + x1.z * x1.z + x1.w * x1.w, red) * (1.f / DM) + EPS);
    bf16_t* o = H2 + (size_t)row * DM + tid * 4;
    o[0] = f2bf(x1.x * r2 * c.x); o[1] = f2bf(x1.y * r2 * c.y); o[2] = f2bf(x1.z * r2 * c.z); o[3] = f2bf(x1.w * r2 * c.w);
}
__global__ void __launch_bounds__(256) nk_final(const float* raw, const float* g, float* out) {
    __shared__ float red[8];
    const int row = blockIdx.x, tid = threadIdx.x;
    const float4 m = ((const float4*)(raw + (size_t)row * DM))[tid];
    const float r = rsqrtf(block_sum<256>(m.x * m.x + m.y * m.y + m.z * m.z + m.w * m.w, red) * (1.f / DM) + EPS);
    const float4 gg = ((const float4*)g)[tid]; float4 x1 = ((float4*)(out + (size_t)row * DM))[tid];
    x1.x += m.x * r * gg.x; x1.y += m.y * r * gg.y; x1.z += m.z * r * gg.z; x1.w += m.w * r * gg.w;
    ((float4*)(out + (size_t)row * DM))[tid] = x1;
}

extern "C" void kernel_launch(void* const* d_in, const int* in_sizes, int n_in, void* d_out, int out_size, void* d_ws, size_t ws_size, hipStream_t stream) {
    if (n_in != 12 || ws_size < WS_END) { fprintf(stderr, "kernel_launch: unexpected inputs (%d) or workspace (%zu)\n", n_in, ws_size); return; }
    const float* x = (const float*)d_in[0]; const float* g_pre = (const float*)d_in[1]; const float* w_in = (const float*)d_in[2]; const float* w_out = (const float*)d_in[3];
    const float* g_post = (const float*)d_in[4]; const float* lbp = (const float*)d_in[5]; const float* g_hg = (const float*)d_in[6]; const float* g_pre_ffn = (const float*)d_in[7];
    const float* w_gate = (const float*)d_in[8]; const float* w_up = (const float*)d_in[9]; const float* w_down = (const float*)d_in[10]; const float* g_post_ffn = (const float*)d_in[11];
    unsigned char* ws = (unsigned char*)d_ws; float* out = (float*)d_out;
    float* rope = (float*)(ws + WS_TAB); float* lb = rope + 2048 * 16;
    bf16_t* W1t = (bf16_t*)(ws + WS_W1); bf16_t* Wot = (bf16_t*)(ws + WS_WO); bf16_t* Wgut = (bf16_t*)(ws + WS_WGU); bf16_t* Wdt = (bf16_t*)(ws + WS_WD);
    bf16_t* XN = (bf16_t*)(ws + WS_XN); bf16_t* CAT = (bf16_t*)(ws + WS_CAT); bf16_t* Kb = (bf16_t*)(ws + WS_K); bf16_t* Vb = (bf16_t*)(ws + WS_V);
    bf16_t* QI = (bf16_t*)(ws + WS_QI); bf16_t* KI = (bf16_t*)(ws + WS_KI); float* WI = (float*)(ws + WS_WI); bf16_t* HV = (bf16_t*)(ws + WS_HV); bf16_t* HG = (bf16_t*)(ws + WS_HG);
    unsigned* MASK = (unsigned*)(ws + WS_MASK); float* TMP = (float*)(ws + WS_TMP); bf16_t* FF = (bf16_t*)(ws + WS_FF);
    float* LOGF = out; float* O = out + (size_t)M * 512;

    nk_tables<<<64, 256, 0, stream>>>(rope, lb, lbp);
    nk_convert<<<(unsigned)(((size_t)NINP * DM + 255) / 256), 256, 0, stream>>>(w_in, nullptr, W1t, NINP, DM, 0);
    nk_convert<<<(unsigned)(((size_t)DM * DM + 255) / 256), 256, 0, stream>>>(w_out, nullptr, Wot, DM, DM, 1);
    nk_convert<<<(unsigned)(((size_t)2 * DFF * DM + 255) / 256), 256, 0, stream>>>(w_gate, w_up, Wgut, 2 * DFF, DM, 2);
    nk_convert<<<(unsigned)(((size_t)DM * DFF + 255) / 256), 256, 0, stream>>>(w_down, nullptr, Wdt, DM, DFF, 3);
    nk_rmsnorm_bf16<<<M, 256, 0, stream>>>(x, g_pre, XN);
    G1Out go{CAT, Kb, Vb, QI, KI, WI, LOGF, HV, HG, rope, lb};
    for (int c0 = 0; c0 < NINP; c0 += 1024) {
        const int nc = (NINP - c0) < 1024 ? (NINP - c0) : 1024;
        nk_gemm<0, EpiRawF32><<<dim3(nc / 64, M / 64), 256, 0, stream>>>(XN, W1t + (size_t)c0 * DM, DM, EpiRawF32{TMP, 1024});
        nk_g1_transform<<<(unsigned)(((size_t)M * nc + 255) / 256), 256, 0, stream>>>(TMP, c0, nc, go);
    }
    nk_indexer<<<M, 256, 0, stream>>>(QI, KI, WI, MASK);
    nk_attention<<<M, 256, 0, stream>>>(CAT, Kb, Vb, MASK);
    nk_hgrn_scan<<<BATCH * 4, 512, 0, stream>>>(CAT, LOGF, HV, O);
    nk_hgrn_out<<<M * 4, 128, 0, stream>>>(O, HG, g_hg, CAT);
    nk_gemm<0, EpiRawF32><<<dim3(DM / 64, M / 64), 256, 0, stream>>>(CAT, Wot, DM, EpiRawF32{TMP, 1024});
    nk_post_mix<<<M, 256, 0, stream>>>(TMP, x, g_post, g_pre_ffn, out, XN);
    nk_gemm<1, EpiSwiglu><<<dim3(DFF / 64, M / 64), 256, 0, stream>>>(XN, Wgut, DM, EpiSwiglu{FF});
    nk_gemm<0, EpiRawF32><<<dim3(DM / 64, M / 64), 256, 0, stream>>>(FF, Wdt, DFF, EpiRawF32{TMP, 1024});
    nk_final<<<M, 256, 0, stream>>>(TMP, g_post_ffn, out);
}
```

```cpp
#include <hip/hip_runtime.h>
#include <cstdint>
#include <cstdio>

typedef unsigned short bf16_t;
constexpr int BATCH = 8, SEQ = 2048, DM = 1024, M = BATCH * SEQ;
constexpr int NIN = 3400, NINP = 3584, DFF = 2816;
constexpr float C2 = 0.125f * 1.4426950408889634f;
constexpr float IDX_SCALE = 0.04419417382415922f;
constexpr float EPS = 1e-6f;

__host__ __device__ inline int w1_src_col(int n) {
    if (n < 1280) return n;
    if (n < 3328) return 1352 + (n - 1280);
    if (n < 3392) return 1280 + (n - 3328);
    if (n < 3400) return 1344 + (n - 3392);
    return -1;
}

constexpr size_t MiB = 1u << 20;
constexpr size_t WS_CTL = 0, WS_TAB = 1 * MiB, WS_W1 = 2 * MiB, WS_WO = 9 * MiB, WS_WGU = 11 * MiB, WS_WD = 22 * MiB;
constexpr size_t WS_XN = 28 * MiB;
constexpr size_t WS_CAT = 60 * MiB;
constexpr size_t WS_K = 92 * MiB, WS_V = 96 * MiB, WS_QI = 100 * MiB, WS_KI = 116 * MiB, WS_WI = 118 * MiB, WS_G = 119 * MiB;
constexpr size_t WS_HV = 120 * MiB, WS_HG = 136 * MiB, WS_MASK = 152 * MiB, WS_TMP = 160 * MiB;
constexpr size_t WS_FF = 60 * MiB;
constexpr size_t WS_VT = 224 * MiB;
constexpr size_t WS_QT = 28 * MiB, WS_KT = 44 * MiB;
constexpr size_t WS_END = 240 * MiB;

__device__ __host__ inline bf16_t f2bf(float f) { unsigned u = __builtin_bit_cast(unsigned, f); return (bf16_t)((u + 0x7fffu + ((u >> 16) & 1u)) >> 16); }
__device__ __host__ inline float bf2f(bf16_t h) { return __builtin_bit_cast(float, (unsigned)h << 16); }
__device__ inline float silu_f(float x) { return x / (1.f + __expf(-x)); }
__device__ inline float sigmoid_f(float x) { return 1.f / (1.f + __expf(-x)); }

template <int NT> __device__ inline float block_sum(float v, float* red) {
#pragma unroll
    for (int o = 32; o > 0; o >>= 1) v += __shfl_xor(v, o);
    __syncthreads();
    if ((threadIdx.x & 63) == 0) red[threadIdx.x >> 6] = v;
    __syncthreads();
    float s = 0.f;
#pragma unroll
    for (int i = 0; i < NT / 64; ++i) s += red[i];
    return s;
}
template <int NT> __device__ inline float block_max(float v, float* red) {
#pragma unroll
    for (int o = 32; o > 0; o >>= 1) v = fmaxf(v, __shfl_xor(v, o));
    __syncthreads();
    if ((threadIdx.x & 63) == 0) red[threadIdx.x >> 6] = v;
    __syncthreads();
    float s = red[0];
#pragma unroll
    for (int i = 1; i < NT / 64; ++i) s = fmaxf(s, red[i]);
    return s;
}

__device__ inline void sincos_taylor(double r, double& s, double& c) {
    const double r2 = r * r; double ts = r, tc = 1.0; s = r; c = 1.0;
#pragma unroll
    for (int k = 1; k <= 14; ++k) { tc = -tc * r2 / (double)((2 * k - 1) * (2 * k)); ts = -ts * r2 / (double)((2 * k) * (2 * k + 1)); c += tc; s += ts; }
}
__global__ void nk_tables(float* rope, float* lb, const float* lbp) {
    const int i = blockIdx.x * blockDim.x + threadIdx.x;
    if (i < 2048 * 8) {
        const int pos = i >> 3, j = i & 7;
        const float inv = powf(500000.0f, -(float)j / 8.0f);
        const float ang = (float)pos * inv;
        const double a = (double)ang, twopi = 6.283185307179586476925;
        const double n = rint(a / twopi), r = a - n * twopi;
        double s, c; sincos_taylor(r, s, c);
        rope[2 * i] = (float)c; rope[2 * i + 1] = (float)s;
    }
    if (i < 512) { const float a = lbp[i], b = lbp[512 + i]; const float m = fmaxf(a, b); const float ea = expf(a - m), eb = expf(b - m); lb[i] = ea / (ea + eb); }
}

__global__ void nk_convert(const float* s0, const float* s1, bf16_t* dst, int N, int K, int mode) {
    const size_t idx = blockIdx.x * (size_t)blockDim.x + threadIdx.x; if (idx >= (size_t)N * K) return;
    const int n = (int)(idx % N), k = (int)(idx / N);
    const float* s = s0; int c = n, ncols = N;
    if (mode == 0) { c = w1_src_col(n); ncols = NIN; }
    else if (mode == 2) { const int t = n >> 8, w = n & 255; if (w < 128) c = t * 128 + w; else { s = s1; c = t * 128 + w - 128; } ncols = DFF; }
    const float v = (c >= 0) ? s[(size_t)k * ncols + c] : 0.f;
    dst[(size_t)n * K + k] = f2bf(v);
}

__global__ void __launch_bounds__(256) nk_rmsnorm_bf16(const float* x, const float* g, bf16_t* out) {
    __shared__ float red[8];
    const int row = blockIdx.x, tid = threadIdx.x;
    const float4 v = ((const float4*)(x + (size_t)row * DM))[tid];
    const float ss = block_sum<256>(v.x * v.x + v.y * v.y + v.z * v.z + v.w * v.w, red);
    const float r = rsqrtf(ss * (1.f / DM) + EPS);
    const float4 gg = ((const float4*)g)[tid];
    bf16_t* o = out + (size_t)row * DM + tid * 4;
    o[0] = f2bf(v.x * r * gg.x); o[1] = f2bf(v.y * r * gg.y); o[2] = f2bf(v.z * r * gg.z); o[3] = f2bf(v.w * r * gg.w);
}

struct EpiRawF32 { float* C; int ldc; __device__ void operator()(int r, int c, float v, float) const { C[(size_t)r * ldc + c] = v; } };
struct EpiSwiglu { bf16_t* FF; __device__ void operator()(int r, int c, float g, float u) const { FF[(size_t)r * DFF + c] = f2bf(silu_f(g) * u); } };
template <int DUAL, class Epi>
__global__ void __launch_bounds__(256) nk_gemm(const bf16_t* A, const bf16_t* Bt, int K, Epi epi) {
    __shared__ float As[16][68], Bs[16][68], Bs2[16][68];
    const int tid = threadIdx.x, tx = tid & 15, ty = tid >> 4;
    const int m0 = blockIdx.y * 64, n0 = blockIdx.x * 64;
    const int bn0 = DUAL ? ((n0 >> 7) * 256 + (n0 & 127)) : n0;
    float acc[4][4], acc2[4][4];
#pragma unroll
    for (int i = 0; i < 4; ++i)
#pragma unroll
        for (int j = 0; j < 4; ++j) { acc[i][j] = 0.f; acc2[i][j] = 0.f; }
    const int lr = tid >> 2, lk = (tid & 3) * 4;
    for (int k0 = 0; k0 < K; k0 += 16) {
        { const ushort4 va = *(const ushort4*)(A + (size_t)(m0 + lr) * K + k0 + lk);
          As[lk][lr] = bf2f(va.x); As[lk + 1][lr] = bf2f(va.y); As[lk + 2][lr] = bf2f(va.z); As[lk + 3][lr] = bf2f(va.w);
          const ushort4 vb = *(const ushort4*)(Bt + (size_t)(bn0 + lr) * K + k0 + lk);
          Bs[lk][lr] = bf2f(vb.x); Bs[lk + 1][lr] = bf2f(vb.y); Bs[lk + 2][lr] = bf2f(vb.z); Bs[lk + 3][lr] = bf2f(vb.w);
          if (DUAL) { const ushort4 vc = *(const ushort4*)(Bt + (size_t)(bn0 + 128 + lr) * K + k0 + lk);
              Bs2[lk][lr] = bf2f(vc.x); Bs2[lk + 1][lr] = bf2f(vc.y); Bs2[lk + 2][lr] = bf2f(vc.z); Bs2[lk + 3][lr] = bf2f(vc.w); } }
        __syncthreads();
#pragma unroll
        for (int kk = 0; kk < 16; ++kk) {
            float a[4], b[4], b2[4];
#pragma unroll
            for (int i = 0; i < 4; ++i) { a[i] = As[kk][ty * 4 + i]; b[i] = Bs[kk][tx * 4 + i]; b2[i] = DUAL ? Bs2[kk][tx * 4 + i] : 0.f; }
#pragma unroll
            for (int i = 0; i < 4; ++i)
#pragma unroll
                for (int j = 0; j < 4; ++j) { acc[i][j] += a[i] * b[j]; if (DUAL) acc2[i][j] += a[i] * b2[j]; }
        }
        __syncthreads();
    }
#pragma unroll
    for (int i = 0; i < 4; ++i)
#pragma unroll
        for (int j = 0; j < 4; ++j) epi(m0 + ty * 4 + i, n0 + tx * 4 + j, acc[i][j], acc2[i][j]);
}

struct G1Out { bf16_t* CAT; bf16_t* K; bf16_t* V; bf16_t* QI; bf16_t* KI; float* WI; float* LOGF; bf16_t* HV; bf16_t* HG; const float* rope; const float* lb; };
__global__ void nk_g1_transform(const float* TMP, int c0, int ncols, G1Out o) {
    const size_t idx = blockIdx.x * (size_t)blockDim.x + threadIdx.x; if (idx >= (size_t)M * ncols) return;
    const int lc = (int)(idx % ncols), row = (int)(idx / ncols), pc = c0 + lc, pos = row & (SEQ - 1);
    const float val = TMP[(size_t)row * 1024 + lc];
    auto roped = [&](int d) -> float {
        if (d >= 16) return val;
        const int j = d & 7; const float cs = o.rope[(pos * 8 + j) * 2], sn = o.rope[(pos * 8 + j) * 2 + 1];
        if (d < 8) { const float v2 = TMP[(size_t)row * 1024 + lc + 8]; return val * cs - v2 * sn; }
        const float v1 = TMP[(size_t)row * 1024 + lc - 8]; return val * cs + v1 * sn;
    };
    if (pc < 512) { o.CAT[(size_t)row * 1024 + pc] = f2bf(roped(pc & 63) * C2); }
    else if (pc < 640) { o.K[(size_t)row * 128 + pc - 512] = f2bf(roped((pc - 512) & 63)); }
    else if (pc < 768) { o.V[(size_t)row * 128 + pc - 640] = f2bf(val); }
    else if (pc < 1280) { o.QI[(size_t)row * 512 + pc - 768] = f2bf(roped((pc - 768) & 63)); }
    else if (pc < 1792) { o.CAT[(size_t)row * 1024 + 512 + pc - 1280] = f2bf(silu_f(val)); }
    else if (pc < 2304) { const int j = pc - 1792; const float l = o.lb[j]; const float f = l + (1.f - l) * sigmoid_f(val); o.LOGF[(size_t)row * 512 + j] = logf(f); }
    else if (pc < 2816) { o.HV[(size_t)row * 512 + pc - 2304] = f2bf(val); }
    else if (pc < 3328) { o.HG[(size_t)row * 512 + pc - 2816] = f2bf(silu_f(val)); }
    else if (pc < 3392) { o.KI[(size_t)row * 64 + pc - 3328] = f2bf(roped(pc - 3328)); }
    else if (pc < 3400) { o.WI[(size_t)row * 8 + pc - 3392] = val * IDX_SCALE; }
}

__device__ inline unsigned fkey(float x) { const unsigned u = __float_as_uint(x); return (u & 0x80000000u) ? ~u : (u | 0x80000000u); }
__global__ void __launch_bounds__(256) nk_indexer(const bf16_t* QI, const bf16_t* KI, const float* WI, unsigned* MASK) {
    __shared__ float qs[512]; __shared__ float wsh[8]; __shared__ unsigned keys[2048]; __shared__ float red[8];
    const int row = blockIdx.x, b = row >> 11, t = row & 2047, tid = threadIdx.x;
    for (int i = tid; i < 512; i += 256) qs[i] = bf2f(QI[(size_t)row * 512 + i]);
    if (tid < 8) wsh[tid] = WI[(size_t)row * 8 + tid];
    __syncthreads();
    for (int s = tid; s < 2048; s += 256) {
        unsigned key = 0u;
        if (s <= t) {
            const bf16_t* kr = KI + (size_t)(b * 2048 + s) * 64;
            float dot[8];
#pragma unroll
            for (int h = 0; h < 8; ++h) dot[h] = 0.f;
#pragma unroll 4
            for (int d = 0; d < 64; ++d) { const float kd = bf2f(kr[d]);
#pragma unroll
                for (int h = 0; h < 8; ++h) dot[h] += qs[h * 64 + d] * kd; }
            float sc = 0.f;
#pragma unroll
            for (int h = 0; h < 8; ++h) sc += wsh[h] * fmaxf(dot[h], 0.f);
            if (sc == 0.f) sc = 0.f;
            key = fkey(sc);
        }
        keys[s] = key;
    }
    __syncthreads();
    unsigned T = 1u;
    if (t + 1 > 256) {
        T = 0u;
        for (int bit = 31; bit >= 0; --bit) {
            const unsigned cand = T | (1u << bit); int c = 0;
            for (int s = tid; s < 2048; s += 256) c += (keys[s] >= cand) ? 1 : 0;
            const int tot = (int)block_sum<256>((float)c, red);
            if (tot >= 256) T = cand;
        }
        int c = 0;
        for (int s = tid; s < 2048; s += 256) c += (keys[s] > T) ? 1 : 0;
        const int cgt = (int)block_sum<256>((float)c, red);
        c = 0;
        for (int s = tid; s < 2048; s += 256) c += (keys[s] >= T) ? 1 : 0;
        const int cge = (int)block_sum<256>((float)c, red);
        if (cge != 256) {
            __syncthreads();
            if (tid == 0) { int need = 256 - cgt; for (int s = 0; s < 2048; ++s) if (keys[s] == T) { if (need > 0) --need; else keys[s] = 0u; } }
            __syncthreads();
        }
    }
    if (tid < 64) { unsigned w = 0u; for (int j = 0; j < 32; ++j) if (keys[32 * tid + j] >= T) w |= (1u << j); MASK[(size_t)row * 64 + tid] = w; }
}

__global__ void __launch_bounds__(256) nk_attention(bf16_t* CAT, const bf16_t* Kb, const bf16_t* Vb, const unsigned* MASK) {
    __shared__ int idx[256]; __shared__ float p[8][256]; __shared__ float qs[512]; __shared__ float red[8]; __shared__ int Lsh;
    const int row = blockIdx.x, b = row >> 11, tid = threadIdx.x;
    for (int i = tid; i < 512; i += 256) qs[i] = bf2f(CAT[(size_t)row * 1024 + i]);
    if (tid < 64) {
        unsigned w = MASK[(size_t)row * 64 + tid]; const int c = __popc(w); int inc = c;
#pragma unroll
        for (int o = 1; o < 64; o <<= 1) { const int v = __shfl_up(inc, o); if (tid >= o) inc += v; }
        int pos = inc - c;
        while (w) { const int j = __ffs(w) - 1; if (pos < 256) idx[pos] = 32 * tid + j; ++pos; w &= w - 1; }
        if (tid == 63) Lsh = inc < 256 ? inc : 256;
    }
    __syncthreads();
    const int L = Lsh; const bool act = tid < L; const int s = act ? idx[tid] : 0;
    float sc[8];
#pragma unroll
    for (int g = 0; g < 2; ++g) {
        const bf16_t* kr = Kb + (size_t)(b * 2048 + s) * 128 + g * 64;
        float d4[4] = {0.f, 0.f, 0.f, 0.f};
#pragma unroll 4
        for (int d = 0; d < 64; ++d) { const float kd = bf2f(kr[d]);
#pragma unroll
            for (int hh = 0; hh < 4; ++hh) d4[hh] += qs[(4 * g + hh) * 64 + d] * kd; }
#pragma unroll
        for (int hh = 0; hh < 4; ++hh) sc[4 * g + hh] = d4[hh];
    }
#pragma unroll
    for (int h = 0; h < 8; ++h) {
        const float m = block_max<256>(act ? sc[h] : -INFINITY, red);
        const float e = act ? exp2f(sc[h] - m) : 0.f;
        const float sum = block_sum<256>(e, red);
        p[h][tid] = e / sum;
    }
    __syncthreads();
#pragma unroll
    for (int rep = 0; rep < 2; ++rep) {
        const int oi = tid + 256 * rep, h = oi >> 6, d = oi & 63; float acc = 0.f;
#pragma unroll 4
        for (int j = 0; j < L; ++j) acc += p[h][j] * bf2f(Vb[(size_t)(b * 2048 + idx[j]) * 128 + (h >> 2) * 64 + d]);
        CAT[(size_t)row * 1024 + oi] = f2bf(acc);
    }
}

__global__ void __launch_bounds__(512) nk_hgrn_scan(const bf16_t* CAT, const float* LOGF, const bf16_t* HV, float* O) {
    __shared__ float qf[128], ff[128], vv[128], part[4][128];
    const int b = blockIdx.x >> 2, h = blockIdx.x & 3, tid = threadIdx.x, v = tid & 127, kq = tid >> 7;
    float S[32];
#pragma unroll
    for (int i = 0; i < 32; ++i) S[i] = 0.f;
    for (int t = 0; t < SEQ; ++t) {
        const size_t row = (size_t)b * SEQ + t;
        if (tid < 128) { qf[tid] = bf2f(CAT[row * 1024 + 512 + h * 128 + tid]); ff[tid] = expf(LOGF[row * 512 + h * 128 + tid]); vv[tid] = bf2f(HV[row * 512 + h * 128 + tid]); }
        __syncthreads();
        const float vval = vv[v]; float po = 0.f;
#pragma unroll
        for (int i = 0; i < 32; ++i) { const int k = kq * 32 + i; const float f = ff[k]; S[i] = f * S[i] + (1.f - f) * vval; po += S[i] * qf[k]; }
        part[kq][v] = po;
        __syncthreads();
        if (tid < 128) O[row * 512 + h * 128 + tid] = (part[0][tid] + part[1][tid]) + (part[2][tid] + part[3][tid]);
    }
}
__global__ void __launch_bounds__(128) nk_hgrn_out(const float* O, const bf16_t* HG, const float* gain, bf16_t* CAT) {
    __shared__ float red[8];
    const int row = blockIdx.x >> 2, h = blockIdx.x & 3, tid = threadIdx.x;
    const float o = O[(size_t)row * 512 + h * 128 + tid];
    const float ss = block_sum<128>(o * o, red);
    const float r = rsqrtf(ss * (1.f / 128.f) + EPS);
    CAT[(size_t)row * 1024 + 512 + h * 128 + tid] = f2bf(o * r * gain[h * 128 + tid] * bf2f(HG[(size_t)row * 512 + h * 128 + tid]));
}

__global__ void __launch_bounds__(256) nk_post_mix(const float* mix, const float* x, const float* g1, const float* g2, float* out, bf16_t* H2) {
    __shared__ float red[8];
    const int row = blockIdx.x, tid = threadIdx.x;
    const float4 m = ((const float4*)(mix + (size_t)row * DM))[tid];
    const float r1 = rsqrtf(block_sum<256>(m.x * m.x + m.y * m.y + m.z * m.z + m.w * m.w, red) * (1.f / DM) + EPS);
    const float4 xv = ((const float4*)(x + (size_t)row * DM))[tid], a = ((const float4*)g1)[tid], c = ((const float4*)g2)[tid];
    float4 x1; x1.x = xv.x + m.x * r1 * a.x; x1.y = xv.y + m.y * r1 * a.y; x1.z = xv.z + m.z * r1 * a.z; x1.w = xv.w + m.w * r1 * a.w;
    ((float4*)(out + (size_t)row * DM))[tid] = x1;
    const float r2 = rsqrtf(block_sum<256>(x1.x * x1.x + x1.y * x1.y + x1.z * x1.z + x1.w * x1.w, red) * (1.f / DM) + EPS);
    bf16_t* o = H2 + (size_t)row * DM + tid * 4;
    o[0] = f2bf(x1.x * r2 * c.x); o[1] = f2bf(x1.y * r2 * c.y); o[2] = f2bf(x1.z * r2 * c.z); o[3] = f2bf(x1.w * r2 * c.w);
}
__global__ void __launch_bounds__(256) nk_final(const float* raw, const float* g, float* out) {
    __shared__ float red[8];
    const int row = blockIdx.x, tid = threadIdx.x;
    const float4 m = ((const float4*)(raw + (size_t)row * DM))[tid];
    const float r = rsqrtf(block_sum<256>(m.x * m.x + m.y * m.y + m.z * m.z + m.w * m.w, red) * (1.f / DM) + EPS);
    const float4 gg = ((const float4*)g)[tid]; float4 x1 = ((float4*)(out + (size_t)row * DM))[tid];
    x1.x += m.x * r * gg.x; x1.y += m.y * r * gg.y; x1.z += m.z * r * gg.z; x1.w += m.w * r * gg.w;
    ((float4*)(out + (size_t)row * DM))[tid] = x1;
}


namespace pg8 {
#define PG8_LAS __attribute__((address_space(3)))
typedef unsigned short bf16_t;
typedef short bf16x8 __attribute__((ext_vector_type(8)));
typedef float f32x4 __attribute__((ext_vector_type(4)));
typedef unsigned u32x4 __attribute__((ext_vector_type(4)));
constexpr int BM = 256, BK = 64, HALF = 128, HTB = HALF * BK * 2  , STAGE_BYTES = 8 * HTB, NXCD = 8, WGM = 8;

__host__ __device__ __forceinline__ int lds_byte(int r, int c) { const int st = (r >> 4) * 2 + (c >> 5), rr = r & 15, cc = c & 31, ob = rr * 64 + cc * 2; return st * 1024 + (ob ^ (((ob >> 9) & 1) << 5)); }
__host__ __device__ __forceinline__ void stage_rc(int b, int& R, int& C) { const int st = b / 1024, sb = b % 1024, swz = sb ^ (((sb >> 9) & 1) << 5); R = (st >> 1) * 16 + swz / 64; C = (st & 1) * 32 + (swz % 64) / 2; }
__host__ __device__ __forceinline__ int perm32(int rho) { const int n = rho >> 4, i = rho & 15; return 8 * (i >> 2) + 4 * n + (i & 3); }

struct Unit { int pm, pn; };
struct Gemm { const bf16_t* A; const bf16_t* Bt; int M, N, K; };

struct StaticOrder {
    int nM, nN, nwg, G, c;
    __host__ __device__ void init(int M, int N, int G_, int c_) { nM = M / BM; nN = N / BM; nwg = nM * nN; G = G_; c = c_; }
    __host__ __device__ bool next(int i, Unit& u) const {
        const long L = (long)i * G + c; if (L >= nwg) return false;
        int wgid = (int)L; { const int q = nwg / NXCD, r = nwg % NXCD, xcd = wgid % NXCD, off = wgid / NXCD; wgid = (xcd < r ? xcd * (q + 1) : r * (q + 1) + (xcd - r) * q) + off; }
        const int nig = WGM * nN, gid = wgid / nig, fm = gid * WGM, gsz = (nM - fm) < WGM ? (nM - fm) : WGM;
        u.pm = fm + ((wgid % nig) % gsz); u.pn = (wgid % nig) / gsz; return true;
    }
    __device__ __forceinline__ void a_ready(const Unit&) const {}
    __device__ __forceinline__ void done(const Unit&) const {}
};


__device__ __forceinline__ unsigned cvt_pk_bf16(float lo, float hi) { unsigned r; asm volatile("v_cvt_pk_bf16_f32 %0, %1, %2" : "=v"(r) : "v"(lo), "v"(hi)); return r; }
__device__ __forceinline__ void st8_bf16(bf16_t* p, const f32x4 v0, const f32x4 v1) {
    u32x4 w; w.x = cvt_pk_bf16(v0[0], v0[1]); w.y = cvt_pk_bf16(v0[2], v0[3]); w.z = cvt_pk_bf16(v1[0], v1[1]); w.w = cvt_pk_bf16(v1[2], v1[3]); *(u32x4*)p = w;
}
__device__ __forceinline__ float fast_silu(float x) { return x * __builtin_amdgcn_rcpf(1.f + __expf(-x)); }
__device__ __forceinline__ f32x4 silu4(const f32x4 v) { return (f32x4){fast_silu(v[0]), fast_silu(v[1]), fast_silu(v[2]), fast_silu(v[3])}; }
__device__ __forceinline__ void rope8(f32x4& v0, f32x4& v1, const float* rope, int pos, int fq) {
    f32x4 o0, o1;
#pragma unroll
    for (int i = 0; i < 4; ++i) { o0[i] = __shfl_xor(v0[i], 16); o1[i] = __shfl_xor(v1[i], 16); }
    if (fq < 2) {
        const f32x4* t = (const f32x4*)(rope + pos * 16);
        const f32x4 t0 = t[0], t1 = t[1], t2 = t[2], t3 = t[3];
        const float sg = fq == 0 ? -1.f : 1.f;
        v0[0] = v0[0] * t0[0] + sg * o0[0] * t0[1]; v0[1] = v0[1] * t0[2] + sg * o0[1] * t0[3];
        v0[2] = v0[2] * t1[0] + sg * o0[2] * t1[1]; v0[3] = v0[3] * t1[2] + sg * o0[3] * t1[3];
        v1[0] = v1[0] * t2[0] + sg * o1[0] * t2[1]; v1[1] = v1[1] * t2[2] + sg * o1[1] * t2[3];
        v1[2] = v1[2] * t3[0] + sg * o1[2] * t3[1]; v1[3] = v1[3] * t3[2] + sg * o1[3] * t3[3];
    }
}
struct EpiG1 {
    static constexpr bool PERM = true, AFTER_DRAIN = false;
    bf16_t *CAT, *K, *V, *QI, *KI, *HV, *HG; float *WI, *LOGF; const float *rope, *lb;
    __device__ __forceinline__ void operator()(const f32x4 (&acc)[2][2][4][2], const Unit& u, int wr, int wc, int fr, int fq) const {
        const int pn = u.pn, row0 = u.pm * BM + wr * 64 + fr, cl = wc * 32 + 8 * fq;
        const bool rp = (wc & 1) == 0;
#pragma unroll
        for (int ai = 0; ai < 2; ++ai)
#pragma unroll
            for (int m = 0; m < 4; ++m) {
                const int row = row0 + ai * HALF + m * 16, pos = row & 2047;
#pragma unroll
                for (int bj = 0; bj < 2; ++bj) {
                    f32x4 v0 = acc[ai][bj][m][0], v1 = acc[ai][bj][m][1];
                    const int c = pn * 256 + bj * HALF + cl;
                    if (pn <= 1) { if (rp) rope8(v0, v1, rope, pos, fq); v0 = v0 * C2; v1 = v1 * C2; st8_bf16(CAT + (size_t)row * 1024 + c, v0, v1); }
                    else if (pn == 2) { if (bj == 0) { if (rp) rope8(v0, v1, rope, pos, fq); st8_bf16(K + (size_t)row * 128 + cl, v0, v1); } else st8_bf16(V + (size_t)row * 128 + cl, v0, v1); }
                    else if (pn <= 4) { if (rp) rope8(v0, v1, rope, pos, fq); st8_bf16(QI + (size_t)row * 512 + (c - 768), v0, v1); }
                    else if (pn <= 6) { st8_bf16(CAT + (size_t)row * 1024 + 512 + (c - 1280), silu4(v0), silu4(v1)); }
                    else if (pn <= 8) { const int j = c - 1792; const f32x4 l0 = *(const f32x4*)(lb + j), l1 = *(const f32x4*)(lb + j + 4); f32x4 r0, r1;
#pragma unroll
                        for (int i = 0; i < 4; ++i) { r0[i] = logf(l0[i] + (1.f - l0[i]) * __builtin_amdgcn_rcpf(1.f + __expf(-v0[i]))); r1[i] = logf(l1[i] + (1.f - l1[i]) * __builtin_amdgcn_rcpf(1.f + __expf(-v1[i]))); }
                        *(f32x4*)(LOGF + (size_t)row * 512 + j) = r0; *(f32x4*)(LOGF + (size_t)row * 512 + j + 4) = r1; }
                    else if (pn <= 10) { st8_bf16(HV + (size_t)row * 512 + (c - 2304), v0, v1); }
                    else if (pn <= 12) { st8_bf16(HG + (size_t)row * 512 + (c - 2816), silu4(v0), silu4(v1)); }
                    else if (bj == 0) {
                        if (wc < 2) { if (rp) rope8(v0, v1, rope, pos, fq); st8_bf16(KI + (size_t)row * 64 + cl, v0, v1); }
                        else if (wc == 2 && fq == 0) { *(f32x4*)(WI + (size_t)row * 8) = v0 * IDX_SCALE; *(f32x4*)(WI + (size_t)row * 8 + 4) = v1 * IDX_SCALE; }
                    }
                }
            }
    }
};
struct EpiSwigluMk {
    static constexpr bool PERM = true, AFTER_DRAIN = false;
    bf16_t* FF;
    __device__ __forceinline__ void operator()(const f32x4 (&acc)[2][2][4][2], const Unit& u, int wr, int wc, int fr, int fq) const {
        const int row0 = u.pm * BM + wr * 64 + fr, col = u.pn * HALF + wc * 32 + 8 * fq;
#pragma unroll
        for (int ai = 0; ai < 2; ++ai)
#pragma unroll
            for (int m = 0; m < 4; ++m) st8_bf16(FF + (size_t)(row0 + ai * HALF + m * 16) * DFF + col, silu4(acc[ai][0][m][0]) * acc[ai][1][m][0], silu4(acc[ai][0][m][1]) * acc[ai][1][m][1]);
    }
};
struct EpiF32 {
    static constexpr bool PERM = false, AFTER_DRAIN = false;
    float* C; int ldc;
    __device__ __forceinline__ void operator()(const f32x4 (&acc)[2][2][4][2], const Unit& u, int wr, int wc, int fr, int fq) const {
        const int row0 = u.pm * BM + wr * 64 + fr, col0 = u.pn * BM + wc * 32 + 4 * fq;
#pragma unroll
        for (int ai = 0; ai < 2; ++ai)
#pragma unroll
            for (int m = 0; m < 4; ++m) { float* rowp = C + (size_t)(row0 + ai * HALF + m * 16) * ldc + col0;
#pragma unroll
                for (int bj = 0; bj < 2; ++bj)
#pragma unroll
                    for (int n = 0; n < 2; ++n) *(f32x4*)(rowp + bj * HALF + n * 16) = acc[ai][bj][m][n]; }
    }
};
template <class Epi, class Sched, bool ALIGN_EPI = false, bool SP2 = false>
__device__ __forceinline__ void gemm_phase(PG8_LAS unsigned char* lds, const Gemm g, const Sched& S, const Epi& E) {
    const int tid = threadIdx.x, wid = __builtin_amdgcn_readfirstlane(tid >> 6), lane = tid & 63, wr = wid >> 2, wc = wid & 3, fr = lane & 15, fq = lane >> 4;
    const int K = g.K, nt = K / BK;
    unsigned voffA[2], voffB[2];
#pragma unroll
    for (int i = 0; i < 2; ++i) { int R, C; stage_rc(tid * 16 + i * 8192, R, C); const int Rb = Epi::PERM ? ((R & ~31) + perm32(R & 31)) : R;
        voffA[i] = (unsigned)(R * K + C) * 2u; voffB[i] = (unsigned)(Rb * K + C) * 2u; }
    const size_t kstep = (size_t)(BK * 2);
    const size_t hstep = (size_t)HALF * K * 2;
    const size_t tstep = 2 * hstep;
    const unsigned ldsw = (unsigned)wid * 1024u;
    const int aoff = lds_byte(wr * 64 + fr, fq * 8), boff = lds_byte(wc * 32 + fr, fq * 8);
#define PG8_SA(b, h) (((b) * 2 + (h)) * HTB)
#define PG8_SB(b, h) ((4 + (b) * 2 + (h)) * HTB)
#define PG8_STAGE(bufoff, gbase, voff) do { _Pragma("unroll") for (int _i = 0; _i < 2; ++_i) \
        __builtin_amdgcn_global_load_lds((const unsigned*)((const char*)(gbase) + (voff)[_i]), (PG8_LAS unsigned*)(lds + (bufoff) + ldsw + _i * 8192), 16, 0, 0); } while (0)
#define PG8_LDA(dst, b, h) do { _Pragma("unroll") for (int m = 0; m < 4; ++m) _Pragma("unroll") for (int k = 0; k < 2; ++k) dst[m][k] = *(const PG8_LAS bf16x8*)(lds + PG8_SA(b, h) + aoff + m * 2048 + k * 1024); } while (0)
#define PG8_LDB(dst, b, h) do { _Pragma("unroll") for (int n = 0; n < 2; ++n) _Pragma("unroll") for (int k = 0; k < 2; ++k) dst[n][k] = *(const PG8_LAS bf16x8*)(lds + PG8_SB(b, h) + boff + n * 2048 + k * 1024); } while (0)
#define PG8_MMA(ai, bj, At, Bt) do { __builtin_amdgcn_s_setprio(1); _Pragma("unroll") for (int m = 0; m < 4; ++m) _Pragma("unroll") for (int n = 0; n < 2; ++n) _Pragma("unroll") for (int k = 0; k < 2; ++k) \
        acc[ai][bj][m][n] = __builtin_amdgcn_mfma_f32_16x16x32_bf16(Bt[n][k], At[m][k], acc[ai][bj][m][n], 0, 0, 0); __builtin_amdgcn_s_setprio(0); } while (0)
#define PG8_WAIT_V(n) asm volatile("s_waitcnt vmcnt(" #n ")" ::: "memory")
#define PG8_WAIT_L(n) asm volatile("s_waitcnt lgkmcnt(" #n ")" ::: "memory")
#define PG8_BAR __builtin_amdgcn_s_barrier()
#define PG8_SCHED __builtin_amdgcn_sched_barrier(0)
    Unit cur, nxt; int ui = 0;
    if (!S.next(0, cur)) return;
    f32x4 acc[2][2][4][2];
#pragma unroll
    for (int a = 0; a < 2; ++a)
#pragma unroll
        for (int b = 0; b < 2; ++b)
#pragma unroll
            for (int m = 0; m < 4; ++m)
#pragma unroll
                for (int n = 0; n < 2; ++n) acc[a][b][m][n] = (f32x4){0.f, 0.f, 0.f, 0.f};
    bf16x8 At[4][2], B0[2][2], B1[2][2];
    const char* cA = (const char*)g.A + (size_t)cur.pm * tstep; const char* cB = (const char*)g.Bt + (size_t)cur.pn * tstep;
    S.a_ready(cur);
    if constexpr (SP2) {
        PG8_STAGE(PG8_SB(0, 0), cB, voffB); PG8_STAGE(PG8_SB(0, 1), cB + hstep, voffB); PG8_STAGE(PG8_SA(0, 0), cA, voffA); PG8_STAGE(PG8_SA(0, 1), cA + hstep, voffA);
        if (wr == 1) PG8_BAR;
        PG8_WAIT_V(2); PG8_BAR;
        PG8_STAGE(PG8_SB(1, 0), cB + kstep, voffB); PG8_STAGE(PG8_SA(1, 0), cA + kstep, voffA); PG8_STAGE(PG8_SB(1, 1), cB + hstep + kstep, voffB);
        PG8_WAIT_V(6); PG8_BAR;
    } else {
        PG8_STAGE(PG8_SB(0, 0), cB, voffB); PG8_STAGE(PG8_SA(0, 0), cA, voffA); PG8_STAGE(PG8_SB(0, 1), cB + hstep, voffB); PG8_STAGE(PG8_SA(0, 1), cA + hstep, voffA);
        if (wr == 1) PG8_BAR;
        PG8_WAIT_V(4); PG8_BAR;
        PG8_STAGE(PG8_SB(1, 0), cB + kstep, voffB); PG8_STAGE(PG8_SA(1, 0), cA + kstep, voffA); PG8_STAGE(PG8_SB(1, 1), cB + hstep + kstep, voffB);
        PG8_WAIT_V(6); PG8_BAR;
    }
    for (;;) {
        const bool has_next = S.next(ui + 1, nxt);
        const char* nA = has_next ? (const char*)g.A + (size_t)nxt.pm * tstep : cA; const char* nB = has_next ? (const char*)g.Bt + (size_t)nxt.pn * tstep : cB;
        for (int t = 0; t < nt; t += 2) {
            const bool last = (t == nt - 2);
            const char* a1 = cA + (size_t)(t + 1) * kstep;
            const char* a2 = last ? nA : cA + (size_t)(t + 2) * kstep; const char* b2 = last ? nB : cB + (size_t)(t + 2) * kstep;
            const char* a3 = a2 + kstep; const char* b3 = b2 + kstep;
            if (last && has_next) S.a_ready(nxt);
            if constexpr (SP2) {
            PG8_LDB(B0, 0, 0); PG8_LDB(B1, 0, 1); PG8_SCHED; PG8_LDA(At, 0, 0); PG8_STAGE(PG8_SA(1, 1), a1 + hstep, voffA);
            PG8_WAIT_V(8); PG8_WAIT_L(0); PG8_BAR; PG8_MMA(0, 0, At, B0); PG8_MMA(0, 1, At, B1); PG8_BAR; PG8_SCHED;
            PG8_LDA(At, 0, 1); PG8_STAGE(PG8_SB(0, 0), b2, voffB); PG8_STAGE(PG8_SB(0, 1), b2 + hstep, voffB); PG8_STAGE(PG8_SA(0, 0), a2, voffA);
            PG8_WAIT_V(8); PG8_WAIT_L(0); PG8_BAR; PG8_MMA(1, 0, At, B0); PG8_MMA(1, 1, At, B1); PG8_BAR; PG8_SCHED;
            PG8_LDB(B0, 1, 0); PG8_LDB(B1, 1, 1); PG8_SCHED; PG8_LDA(At, 1, 0); PG8_STAGE(PG8_SA(0, 1), a2 + hstep, voffA);
            PG8_WAIT_V(8); PG8_WAIT_L(0); PG8_BAR; PG8_MMA(0, 0, At, B0); PG8_MMA(0, 1, At, B1); PG8_BAR; PG8_SCHED;
            PG8_LDA(At, 1, 1); PG8_STAGE(PG8_SB(1, 0), b3, voffB); PG8_STAGE(PG8_SB(1, 1), b3 + hstep, voffB); PG8_STAGE(PG8_SA(1, 0), a3, voffA);
            PG8_WAIT_V(8); PG8_WAIT_L(0); PG8_BAR; PG8_MMA(1, 0, At, B0); PG8_MMA(1, 1, At, B1); PG8_BAR; PG8_SCHED;
            } else {
            PG8_LDB(B0, 0, 0); PG8_SCHED; PG8_LDA(At, 0, 0); PG8_STAGE(PG8_SA(1, 1), a1 + hstep, voffA);
            PG8_WAIT_L(8); PG8_BAR; PG8_WAIT_L(0); PG8_MMA(0, 0, At, B0); PG8_BAR; PG8_SCHED;
            PG8_LDB(B1, 0, 1); PG8_STAGE(PG8_SB(0, 0), b2, voffB);
            PG8_BAR; PG8_WAIT_L(0); PG8_MMA(0, 1, At, B1); PG8_BAR;
            PG8_LDA(At, 0, 1); PG8_STAGE(PG8_SA(0, 0), a2, voffA);
            PG8_BAR; PG8_WAIT_L(0); PG8_MMA(1, 0, At, B0); PG8_BAR; PG8_SCHED;
            PG8_STAGE(PG8_SB(0, 1), b2 + hstep, voffB);
            PG8_WAIT_V(6); PG8_BAR; PG8_MMA(1, 1, At, B1); PG8_BAR;
            PG8_LDB(B0, 1, 0); PG8_SCHED; PG8_LDA(At, 1, 0); PG8_STAGE(PG8_SA(0, 1), a2 + hstep, voffA);
            PG8_WAIT_L(8); PG8_BAR; PG8_WAIT_L(0); PG8_MMA(0, 0, At, B0); PG8_BAR; PG8_SCHED;
            PG8_LDB(B1, 1, 1); PG8_STAGE(PG8_SB(1, 0), b3, voffB);
            PG8_BAR; PG8_WAIT_L(0); PG8_MMA(0, 1, At, B1); PG8_BAR;
            PG8_LDA(At, 1, 1); PG8_STAGE(PG8_SA(1, 0), a3, voffA);
            PG8_BAR; PG8_WAIT_L(0); PG8_MMA(1, 0, At, B0); PG8_BAR; PG8_SCHED;
            PG8_STAGE(PG8_SB(1, 1), b3 + hstep, voffB);
            PG8_WAIT_V(6); PG8_BAR; PG8_MMA(1, 1, At, B1); PG8_BAR;
            }
        }
        if constexpr (ALIGN_EPI) { if (wr == 0) PG8_BAR; }
        if constexpr (!Epi::AFTER_DRAIN) { E(acc, cur, wr, wc, fr, fq); S.done(cur); }
        if (!has_next) break;
#pragma unroll
        for (int a = 0; a < 2; ++a)
#pragma unroll
            for (int b = 0; b < 2; ++b)
#pragma unroll
                for (int m = 0; m < 4; ++m)
#pragma unroll
                    for (int n = 0; n < 2; ++n) acc[a][b][m][n] = (f32x4){0.f, 0.f, 0.f, 0.f};
        cur = nxt; cA = nA; cB = nB; ++ui;
        if constexpr (ALIGN_EPI) { if (wr == 1) PG8_BAR; }
    }
    PG8_WAIT_V(0);
    if constexpr (!ALIGN_EPI) { if (wr == 0) PG8_BAR; }
    PG8_BAR;
    if constexpr (Epi::AFTER_DRAIN) { E.fused(acc, cur, wr, wc, fr, fq, lds, wid, lane); S.done(cur); }
#undef PG8_SA
#undef PG8_SB
#undef PG8_STAGE
#undef PG8_LDA
#undef PG8_LDB
#undef PG8_MMA
#undef PG8_WAIT_V
#undef PG8_WAIT_L
#undef PG8_BAR
#undef PG8_SCHED
}
}

namespace attn_body {
using bf16=unsigned short;
using bf16x8=__attribute__((ext_vector_type(8)))short;
using s16x4=__attribute__((ext_vector_type(4)))short;
using f32x16=__attribute__((ext_vector_type(16)))float;
using u32x4=__attribute__((ext_vector_type(4)))unsigned;
constexpr int BATCH=8,NHEAD=8,SEQ=2048,D=64,QP=1024,KP=128;
constexpr int NW=8,QBLK=32,QB=QBLK*NW,KVBLK=64,NQB=SEQ/QB;
constexpr int ATTN_PITCH=QP, ATTN_UNIT_ROWS=QB;
__device__ __forceinline__ int crow(int r,int hi){return (r&3)+8*(r>>2)+4*hi;}
#define SBAR() __builtin_amdgcn_sched_barrier(0)
constexpr int NSLOT=3, SLOTB=8192;
constexpr int MROW=264;
constexpr int LDS_K=0, LDS_V=NSLOT*SLOTB, LDS_WS=2*NSLOT*SLOTB, LDS_OST=LDS_WS+NW*64*4, LDS_MSK=LDS_OST+NW*4096, LDS_BYTES=LDS_MSK+QB*MROW;
constexpr float C2=0.125f*1.4426950408889634f;
__device__ __forceinline__ void glds16(const void*gsrc,unsigned lds_dst){unsigned keep;
  asm volatile("s_mov_b32 %0, m0\n\ts_mov_b32 m0, %2\n\ts_nop 0\n\tglobal_load_lds_dwordx4 %1, off\n\ts_mov_b32 m0, %0":"=&s"(keep):"v"(gsrc),"s"(lds_dst):"memory");}
__device__ __forceinline__ float max3f(float a,float b,float c){float r;asm("v_max3_f32 %0, %1, %2, %3":"=v"(r):"v"(a),"v"(b),"v"(c));return r;}
__device__ __forceinline__ float max2f(float a,float b){float r;asm("v_max_f32_e32 %0, %1, %2":"=v"(r):"v"(a),"v"(b));return r;}
__device__ __forceinline__ float fadd_s(float a,float b){float r;asm("v_add_f32_e32 %0, %1, %2":"=v"(r):"v"(a),"v"(b));return r;}
__device__ __forceinline__ float fsub_s(float a,float b){float r;asm("v_sub_f32_e32 %0, %1, %2":"=v"(r):"v"(a),"v"(b));return r;}
typedef float f32x2_t __attribute__((ext_vector_type(2))); typedef __bf16 bf16x2_t __attribute__((ext_vector_type(2)));
__device__ __forceinline__ unsigned cvtpk_s(float lo,float hi){f32x2_t v={lo,hi};bf16x2_t b=__builtin_convertvector(v,bf16x2_t);return __builtin_bit_cast(unsigned,b);}
#define WAIT_BAR(N) asm volatile("s_waitcnt vmcnt(" #N ") lgkmcnt(0)\n\ts_barrier":::"memory")

__device__ __forceinline__ void qkt(f32x16&p0,f32x16&p1,const char*Kslot,const bf16x8*qr,const f32x16&negm,int r32,int hi){
  const char*kb=Kslot+hi*1024+r32*16;
  #pragma unroll
  for(int d0=0;d0<4;++d0){
    const bf16x8 b0=*reinterpret_cast<const bf16x8*>(kb+d0*2048);
    const bf16x8 b1=*reinterpret_cast<const bf16x8*>(kb+d0*2048+512);
    if(d0==0){p0=__builtin_amdgcn_mfma_f32_32x32x16_bf16(b0,qr[0],negm,0,0,0);p1=__builtin_amdgcn_mfma_f32_32x32x16_bf16(b1,qr[0],negm,0,0,0);}
    else{p0=__builtin_amdgcn_mfma_f32_32x32x16_bf16(b0,qr[d0],p0,0,0,0);p1=__builtin_amdgcn_mfma_f32_32x32x16_bf16(b1,qr[d0],p1,0,0,0);}}
}
typedef __attribute__((address_space(3))) const char* lds_cptr;
typedef short v4i16_t __attribute__((ext_vector_type(4)));
__device__ __forceinline__ void kload8(bf16x8*kf,lds_cptr kp){
  kf[0]=*(const __attribute__((address_space(3))) bf16x8*)(kp);      kf[1]=*(const __attribute__((address_space(3))) bf16x8*)(kp+512);
  kf[2]=*(const __attribute__((address_space(3))) bf16x8*)(kp+2048); kf[3]=*(const __attribute__((address_space(3))) bf16x8*)(kp+2560);
  kf[4]=*(const __attribute__((address_space(3))) bf16x8*)(kp+4096); kf[5]=*(const __attribute__((address_space(3))) bf16x8*)(kp+4608);
  kf[6]=*(const __attribute__((address_space(3))) bf16x8*)(kp+6144); kf[7]=*(const __attribute__((address_space(3))) bf16x8*)(kp+6656);
}
__device__ __forceinline__ void kload2(bf16x8*kf,lds_cptr kp,int j){ kf[2*j]=*(const __attribute__((address_space(3))) bf16x8*)(kp+j*2048); kf[2*j+1]=*(const __attribute__((address_space(3))) bf16x8*)(kp+j*2048+512); }
__device__ __forceinline__ s16x4 vtr(lds_cptr p){ return __builtin_bit_cast(s16x4,__builtin_amdgcn_ds_read_tr16_b64_v4i16((__attribute__((address_space(3))) v4i16_t*)p)); }
__device__ __forceinline__ float rowmax(const f32x16&p0,const f32x16&p1){
  float a=max3f(p0[0],p0[1],p1[0]),b=max3f(p0[2],p0[3],p1[1]);a=max3f(a,p1[2],p1[3]);
  #pragma unroll
  for(int r=4;r<16;r+=4){a=max3f(a,p0[r],p0[r+1]);b=max3f(b,p0[r+2],p0[r+3]);a=max3f(a,p1[r],p1[r+1]);b=max3f(b,p1[r+2],p1[r+3]);}
  const float m=max2f(a,b);
  auto rr=__builtin_amdgcn_permlane32_swap(__float_as_uint(m),__float_as_uint(m),false,false);
  return max2f(__uint_as_float(rr[0]),__uint_as_float(rr[1]));
}
__device__ __forceinline__ void pv(f32x16*o,int vb,bf16x8 pa0,bf16x8 pa1,bf16x8 pa2,bf16x8 pa3){
  #pragma unroll
  for(int d0=0;d0<2;++d0){s16x4 lo[4],hi[4];
    #pragma unroll
    for(int ks=0;ks<4;++ks){
      asm volatile("ds_read_b64_tr_b16 %0,%1 offset:%c2":"=&v"(lo[ks]):"v"(vb),"i"(d0*4096+ks*1024):"memory");
      asm volatile("ds_read_b64_tr_b16 %0,%1 offset:%c2":"=&v"(hi[ks]):"v"(vb),"i"(d0*4096+ks*1024+512):"memory");}
    asm volatile("s_waitcnt lgkmcnt(0)":::"memory");SBAR();
    #define PK(k) (bf16x8){lo[k][0],lo[k][1],lo[k][2],lo[k][3],hi[k][0],hi[k][1],hi[k][2],hi[k][3]}
    o[d0]=__builtin_amdgcn_mfma_f32_32x32x16_bf16(pa0,PK(0),o[d0],0,0,0);
    o[d0]=__builtin_amdgcn_mfma_f32_32x32x16_bf16(pa1,PK(1),o[d0],0,0,0);
    o[d0]=__builtin_amdgcn_mfma_f32_32x32x16_bf16(pa2,PK(2),o[d0],0,0,0);
    o[d0]=__builtin_amdgcn_mfma_f32_32x32x16_bf16(pa3,PK(3),o[d0],0,0,0);
    #undef PK
  }
}

#ifndef ATTN_STORE16
#define ATTN_STORE16(p,v) (*(u32x4*)(p)=(v))
#endif
template<int THRL> __device__ __forceinline__ void attn_unit(int b,int h,int qb,const bf16*Q,const bf16*__restrict__ K,const bf16*__restrict__ V,bf16*O,const unsigned*__restrict__ MASK,char*shm){
  const int tid=threadIdx.x,lane=tid&63,r32=lane&31,hi=lane>>5; const int wid=__builtin_amdgcn_readfirstlane(tid>>6);
  const long rowbase=(long)b*SEQ; const int q0=qb*QB;
  const bf16*Qw=Q+(rowbase+q0+wid*QBLK)*QP+h*D;
  const bf16*Kh=K+rowbase*KP+(h>>2)*D,*Vh=V+rowbase*KP+(h>>2)*D;
  const unsigned lds0=(unsigned)(uintptr_t)shm;
  float*wsf=(float*)(shm+LDS_WS)+wid*64;
  const bf16*ksrc=Kh+(long)lane*KP+wid*8;
  const bf16*vsrc=Vh+(long)(16*(wid&3)+(lane>>2))*KP+(wid>>2)*32+(lane&3)*8;
  const unsigned kdst=lds0+LDS_K+wid*1024, vdst=lds0+LDS_V+wid*1024;
  #define DMA_K(t,slot) glds16(ksrc+(long)(t)*KVBLK*KP,(unsigned)__builtin_amdgcn_readfirstlane(kdst+(slot)))
  #define DMA_V(t,slot) glds16(vsrc+(long)(t)*KVBLK*KP,(unsigned)__builtin_amdgcn_readfirstlane(vdst+(slot)))
  const int vb0=(int)(lds0+LDS_V)+((lane>>4)&1)*32+(lane&3)*8+(4*hi+((lane&15)>>2))*64;
  const char*Kbase=shm+LDS_K; bf16x8 kf[8];
  const lds_cptr shm3=(lds_cptr)shm; const lds_cptr kp0=shm3+LDS_K+hi*1024+r32*16; const lds_cptr vp0=shm3+LDS_V+((lane>>4)&1)*32+(lane&3)*8+(4*hi+((lane&15)>>2))*64;
  const int NT=(q0+QB)/KVBLK;
  { const unsigned long long*msrc=(const unsigned long long*)(MASK+(size_t)(rowbase+q0)*64)+(tid>>5)*32+(tid&31);
    __attribute__((address_space(3))) unsigned long long*mdst=(__attribute__((address_space(3))) unsigned long long*)((lds_cptr)shm+LDS_MSK+(tid>>5)*MROW+(tid&31)*8);
    #pragma unroll
    for(int i=0;i<16;++i){ const unsigned long long w=msrc[i*512]; mdst[i*(16*MROW/8)]=w; } }
  const __attribute__((address_space(3))) unsigned long long* mrow=(const __attribute__((address_space(3))) unsigned long long*)((lds_cptr)shm+LDS_MSK+(wid*QBLK+r32)*MROW);
  const int msh=4*hi;
  DMA_K(0,0);DMA_V(0,0);DMA_K(1,SLOTB);
  bf16x8 qr[4];
  #pragma unroll
  for(int d0=0;d0<4;++d0)qr[d0]=*reinterpret_cast<const bf16x8*>(&Qw[(long)r32*QP+d0*16+hi*8]);
  float mhat=0.f,l_reg=0.f;f32x16 o[2];o[0]=f32x16{};o[1]=f32x16{};f32x16 negm=f32x16{};asm volatile("":"+v"(negm));
  bool resc=false;
  #define MBIT(W,k) ((unsigned)(((int)((W)<<(31-(k))))>>31))
  #define MEXP(v,W,k) __uint_as_float(__float_as_uint(__builtin_amdgcn_exp2f(v))&MBIT(W,k))
  #define START(P0,P1) do{ const float rm=rowmax(P0,P1); resc=false; \
    { const float dl=rm; mhat=fadd_s(mhat,dl); \
      _Pragma("unroll") for(int r=0;r<16;++r){P0[r]=fsub_s(P0[r],dl);P1[r]=fsub_s(P1[r],dl);} \
      _Pragma("unroll") for(int r=0;r<16;++r)negm[r]=-mhat; asm volatile("":"+v"(negm)); } \
    _Pragma("unroll") for(int r=0;r<16;++r)P0[r]=MEXP(P0[r],mw0,(r&3)+8*(r>>2)); }while(0)
  #define RESC() do{ if(resc){ asm volatile("s_waitcnt lgkmcnt(0)":::"memory"); \
      _Pragma("unroll") for(int d_=0;d_<2;++d_) _Pragma("unroll") for(int r=0;r<16;++r)o[d_][r]*=wsf[crow(r,hi)]; } }while(0)
  f32x16 pA0,pA1,pB0,pB1;
  int sl_prev=0,sl_cur=0,sl_next=SLOTB;
  #define ROT() do{sl_prev=sl_cur;sl_cur=sl_next;sl_next=(sl_next==(NSLOT-1)*SLOTB)?0:sl_next+SLOTB;}while(0)
  DMA_K(2,2*SLOTB);
  WAIT_BAR(3);
  unsigned mw0,mw1; { const unsigned long long mw=mrow[0]; mw0=(unsigned)mw>>msh; mw1=(unsigned)(mw>>32)>>msh; }
  qkt(pA0,pA1,Kbase,qr,negm,r32,hi);asm volatile("s_nop 15\n\ts_nop 7":"+v"(pA0),"+v"(pA1));
  START(pA0,pA1);
  _Pragma("unroll") for(int r=0;r<16;++r)pA1[r]=MEXP(pA1[r],mw1,(r&3)+8*(r>>2));
  WAIT_BAR(0);
  DMA_K(3,0);DMA_V(1,SLOTB);
  ROT();
  kload8(kf,kp0+sl_cur);
  WAIT_BAR(2);
  s16x4 vlo[8],vhi[8]; u32x4 pw0,pw1,pw2,pw3;
  #define PKW(P,B) cvtpk_s(P[B],P[B+1])
  #define PAF(k) __builtin_bit_cast(bf16x8,pw##k)
  #define VFR(i) (bf16x8){vlo[i][0],vlo[i][1],vlo[i][2],vlo[i][3],vhi[i][0],vhi[i][1],vhi[i][2],vhi[i][3]}
  #define PIN(x) asm volatile("":"+v"(x))
  #define MX3(a,b,c) __builtin_fmaxf(__builtin_fmaxf((a),(b)),(c))
  #define GAPA(MF,A0,A1,A2,A3,W0,W1,PW) do{ MF; sacc+=A0; sacc+=A1; sacc+=A2; sacc+=A3; PIN(sacc); W0; W1; PIN(PW); SBAR(); }while(0)
  #define EX(v) __builtin_amdgcn_exp2f(v)
  #define GAPB(MF,X,B,W) do{ MF; X[B]=MEXP(X[B],W,2*(B)); X[B+1]=MEXP(X[B+1],W,2*(B)+1); X[B+2]=MEXP(X[B+2],W,2*(B)+2); X[B+3]=MEXP(X[B+3],W,2*(B)+3); PIN(X); SBAR(); }while(0)
  #define VRD(i) do{ vlo[i]=vtr(vp_+(((i)>>2)*4096+((i)&3)*1024)); vhi[i]=vtr(vp_+(((i)>>2)*4096+((i)&3)*1024+512)); }while(0)
  #define KRD(G,j) do{ if(G){ kload2(kf,kp0+sl_next,j); SBAR(); } }while(0)
  #define STEP(C0,C1,P0,P1,t,GK,GV,GL) do{ SBAR(); \
    const lds_cptr vp_=vp0+sl_prev; \
    VRD(0); SBAR(); float sacc=(P0[0]+P0[1]); \
    GAPA(C0=__builtin_amdgcn_mfma_f32_32x32x16_bf16(kf[0],qr[0],negm,0,0,0), P0[2],P0[3],P0[4],P0[5],     pw0[0]=PKW(P0,0), pw0[1]=PKW(P0,2), pw0); \
    VRD(4); SBAR(); GAPA(C1=__builtin_amdgcn_mfma_f32_32x32x16_bf16(kf[1],qr[0],negm,0,0,0), P0[6],P0[7],P0[8],P0[9],     pw0[2]=PKW(P0,4), pw0[3]=PKW(P0,6), pw0); \
    VRD(1); SBAR(); GAPA(C0=__builtin_amdgcn_mfma_f32_32x32x16_bf16(kf[2],qr[1],C0,0,0,0),   P0[10],P0[11],P0[12],P0[13], pw1[0]=PKW(P0,8), pw1[1]=PKW(P0,10), pw1); \
    VRD(5); SBAR(); GAPA(C1=__builtin_amdgcn_mfma_f32_32x32x16_bf16(kf[3],qr[1],C1,0,0,0),   P0[14],P0[15],P1[0],P1[1],   pw1[2]=PKW(P0,12),pw1[3]=PKW(P0,14), pw1); \
    VRD(2); SBAR(); GAPA(C0=__builtin_amdgcn_mfma_f32_32x32x16_bf16(kf[4],qr[2],C0,0,0,0),   P1[2],P1[3],P1[4],P1[5],     pw2[0]=PKW(P1,0), pw2[1]=PKW(P1,2), pw2); \
    VRD(6); SBAR(); GAPA(C1=__builtin_amdgcn_mfma_f32_32x32x16_bf16(kf[5],qr[2],C1,0,0,0),   P1[6],P1[7],P1[8],P1[9],     pw2[2]=PKW(P1,4), pw2[3]=PKW(P1,6), pw2); \
    VRD(3); SBAR(); GAPA(C0=__builtin_amdgcn_mfma_f32_32x32x16_bf16(kf[6],qr[3],C0,0,0,0),   P1[10],P1[11],P1[12],P1[13], pw3[0]=PKW(P1,8), pw3[1]=PKW(P1,10), pw3); \
    VRD(7); SBAR(); GAPA(C1=__builtin_amdgcn_mfma_f32_32x32x16_bf16(kf[7],qr[3],C1,0,0,0),   P1[14],P1[15],0.f,0.f,       pw3[2]=PKW(P1,12),pw3[3]=PKW(P1,14), pw3); \
    l_reg+=sacc; \
    if(GK){DMA_K((t)+3,sl_cur);} if(GV){DMA_V((t)+1,sl_next);} \
    unsigned mw0,mw1; { const unsigned long long mw_=mrow[(t)]; mw0=(unsigned)mw_>>msh; mw1=(unsigned)(mw_>>32)>>msh; } \
    { float a=MX3(C0[0],C0[1],C1[0]),b=MX3(C0[2],C0[3],C1[1]); a=MX3(a,C1[2],C1[3]); \
      _Pragma("unroll") for(int r=4;r<16;r+=4){a=MX3(a,C0[r],C0[r+1]);b=MX3(b,C0[r+2],C0[r+3]);a=MX3(a,C1[r],C1[r+1]);b=MX3(b,C1[r+2],C1[r+3]);} \
      float rm=__builtin_fmaxf(a,b); { auto rr=__builtin_amdgcn_permlane32_swap(__float_as_uint(rm),__float_as_uint(rm),false,false); rm=__builtin_fmaxf(__uint_as_float(rr[0]),__uint_as_float(rr[1])); } \
      resc=false; \
      if(__builtin_expect(__any(rm>(float)THRL),0)){ const float dl=__builtin_fmaxf(rm,0.f); mhat+=dl; \
        _Pragma("unroll") for(int r=0;r<16;++r){C0[r]-=dl;C1[r]-=dl;} \
        _Pragma("unroll") for(int r=0;r<16;++r)negm[r]=-mhat; asm volatile("":"+v"(negm)); \
        const float f=__builtin_amdgcn_exp2f(-dl); l_reg*=f; if(hi==0)wsf[r32]=f; resc=true; } } \
    SBAR(); \
    GAPB(o[0]=__builtin_amdgcn_mfma_f32_32x32x16_bf16(PAF(0),VFR(0),o[0],0,0,0), C0,0,mw0); \
    GAPB(o[1]=__builtin_amdgcn_mfma_f32_32x32x16_bf16(PAF(0),VFR(4),o[1],0,0,0), C0,4,mw0); \
    KRD(GL,0); GAPB(o[0]=__builtin_amdgcn_mfma_f32_32x32x16_bf16(PAF(1),VFR(1),o[0],0,0,0), C0,8,mw0); \
    KRD(GL,1); GAPB(o[1]=__builtin_amdgcn_mfma_f32_32x32x16_bf16(PAF(1),VFR(5),o[1],0,0,0), C0,12,mw0); \
    KRD(GL,2); GAPB(o[0]=__builtin_amdgcn_mfma_f32_32x32x16_bf16(PAF(2),VFR(2),o[0],0,0,0), C1,0,mw1); \
    KRD(GL,3); GAPB(o[1]=__builtin_amdgcn_mfma_f32_32x32x16_bf16(PAF(2),VFR(6),o[1],0,0,0), C1,4,mw1); \
    GAPB(o[0]=__builtin_amdgcn_mfma_f32_32x32x16_bf16(PAF(3),VFR(3),o[0],0,0,0), C1,8,mw1); \
    GAPB(o[1]=__builtin_amdgcn_mfma_f32_32x32x16_bf16(PAF(3),VFR(7),o[1],0,0,0), C1,12,mw1); \
    }while(0)
  int t=1;
  for(;t+5<NT;t+=2){
    STEP(pB0,pB1,pA0,pA1,t,true,true,true);     WAIT_BAR(2); RESC(); ROT();
    STEP(pA0,pA1,pB0,pB1,t+1,true,true,true);   WAIT_BAR(2); RESC(); ROT();
  }
  #define ENDW(tt) do{ if((tt)+3<NT){WAIT_BAR(2);} else if((tt)+2<NT){WAIT_BAR(1);} else {WAIT_BAR(0);} }while(0)
  for(;t+1<NT;t+=2){
    STEP(pB0,pB1,pA0,pA1,t,(t+3<NT),(t+1<NT),(t+1<NT));       ENDW(t);   RESC(); ROT();
    STEP(pA0,pA1,pB0,pB1,t+1,(t+4<NT),(t+2<NT),(t+2<NT));     ENDW(t+1); RESC(); ROT();
  }
  STEP(pB0,pB1,pA0,pA1,NT-1,false,false,false); RESC();
  { float sacc=pB0[0]+pB0[1]; _Pragma("unroll") for(int r=2;r<16;++r)sacc+=pB0[r]; _Pragma("unroll") for(int r=0;r<16;++r)sacc+=pB1[r]; l_reg+=sacc;
    pw0=(u32x4){PKW(pB0,0),PKW(pB0,2),PKW(pB0,4),PKW(pB0,6)};pw1=(u32x4){PKW(pB0,8),PKW(pB0,10),PKW(pB0,12),PKW(pB0,14)};pw2=(u32x4){PKW(pB1,0),PKW(pB1,2),PKW(pB1,4),PKW(pB1,6)};pw3=(u32x4){PKW(pB1,8),PKW(pB1,10),PKW(pB1,12),PKW(pB1,14)};
    SBAR(); pv(o,vb0+sl_cur,PAF(0),PAF(1),PAF(2),PAF(3)); }
  #undef PKW
  #undef PAF
  #undef VFR
  #undef PIN
  #undef MX3
  #undef GAPA
  #undef GAPB
  #undef EX
  #undef VRD
  #undef KRD
  #undef STEP
  #undef ENDW
  {auto rr=__builtin_amdgcn_permlane32_swap(__float_as_uint(l_reg),__float_as_uint(l_reg),false,false);l_reg=__uint_as_float(rr[0])+__uint_as_float(rr[1]);}
  if(hi==0)wsf[32+r32]=l_reg;asm volatile("s_waitcnt lgkmcnt(0)":::"memory");
  float rli[16];
  #pragma unroll
  for(int r=0;r<16;++r)rli[r]=__builtin_amdgcn_rcpf(wsf[32+crow(r,hi)]);
  bf16*Ow=O+(rowbase+q0+wid*QBLK)*QP+h*D;
  { bf16*stg=(bf16*)(shm+LDS_OST)+wid*2048;
    #pragma unroll
    for(int r=0;r<16;++r){const int orow=crow(r,hi);
      #pragma unroll
      for(int d0=0;d0<2;++d0)stg[orow*64+d0*32+r32]=f2bf(o[d0][r]*rli[r]);}
    asm volatile("s_waitcnt lgkmcnt(0)":::"memory");
    #pragma unroll
    for(int i=0;i<4;++i){const int row=i*8+(lane>>3),ch=lane&7; const u32x4 v=*(const u32x4*)(stg+row*64+ch*8); ATTN_STORE16(Ow+(long)row*QP+ch*8,v);} }
  asm volatile("s_waitcnt lgkmcnt(0)\n\ts_barrier":::"memory");
  #undef DMA_K
  #undef DMA_V
  #undef START
  #undef MBIT
  #undef MEXP
  #undef RESC
  #undef ROT
}
constexpr int ATTN_LDS_BYTES=LDS_BYTES;
struct AttnTensors { const bf16* Q; const bf16* K; const bf16* V; bf16* O; const unsigned* MASK; };
struct AttnUnit { int bh; int qb; };
struct StaticOrder {
  int vcu,nv;
  __device__ __forceinline__ explicit StaticOrder(int grid,int block):vcu((grid%8==0)?(block%8)*(grid/8)+block/8:block),nv(grid){}
  __device__ __forceinline__ bool next(int i,AttnUnit&u)const{ const int p=vcu+(i>>1)*nv; if(p>=256)return false; const int s=p&3; u.bh=p>>2; u.qb=(i&1)?7-s:s; return true; }
  __device__ __forceinline__ void a_ready(const AttnUnit&)const{}
  __device__ __forceinline__ void done(const AttnUnit&)const{}
};
template<class Sched,int THRL=8> __device__ __forceinline__ void attn_phase(char*lds,const AttnTensors&T,const Sched&S){
  AttnUnit u;
  for(int i=0;S.next(i,u);++i){ S.a_ready(u); attn_unit<THRL>(u.bh/NHEAD,u.bh%NHEAD,u.qb,T.Q,T.K,T.V,T.O,T.MASK,lds); S.done(u); }
}
#undef SBAR
#undef WAIT_BAR
}


namespace idx_body {
typedef short bf16x8 __attribute__((ext_vector_type(8)));
typedef float f32x4 __attribute__((ext_vector_type(4)));
typedef unsigned u32x4 __attribute__((ext_vector_type(4)));
#define IDX_LAS __attribute__((address_space(3)))
constexpr int PP = 2052;
constexpr int IDX_LDS_BYTES = 16 * PP * 4;
__device__ __forceinline__ unsigned okey(float x) { const unsigned u = __float_as_uint(x); return (u & 0x80000000u) ? ~u : (u | 0x80000000u); }
__device__ __forceinline__ void idx_unit(int b, int qt, const bf16_t* __restrict__ QI, const bf16_t* __restrict__ KI, const float* __restrict__ WI, unsigned* __restrict__ MASK, IDX_LAS unsigned* panel) {
    const int tid = threadIdx.x, lane = tid & 63, wid = __builtin_amdgcn_readfirstlane(tid >> 6), fr = lane & 15, fq = lane >> 4;
    const int q0 = qt * 16; const size_t rowbase = (size_t)b * SEQ;
    {
        bf16x8 qf[8][2];
        const bf16_t* qrow = QI + (rowbase + q0 + fr) * 512 + fq * 8;
#pragma unroll
        for (int h = 0; h < 8; ++h) { qf[h][0] = *(const bf16x8*)(qrow + h * 64); qf[h][1] = *(const bf16x8*)(qrow + h * 64 + 32); }
        const f32x4 w0 = *(const f32x4*)(WI + (rowbase + q0 + fr) * 8), w1 = *(const f32x4*)(WI + (rowbase + q0 + fr) * 8 + 4);
        const int t = q0 + fr;
        for (int kt = wid; kt <= qt; kt += 8) {
            const bf16_t* krow = KI + (rowbase + kt * 16 + fr) * 64 + fq * 8;
            const bf16x8 a0 = *(const bf16x8*)krow, a1 = *(const bf16x8*)(krow + 32);
            f32x4 sc = (f32x4){0.f, 0.f, 0.f, 0.f};
#pragma unroll
            for (int h = 0; h < 8; ++h) {
                f32x4 acc = __builtin_amdgcn_mfma_f32_16x16x32_bf16(a0, qf[h][0], (f32x4){0.f, 0.f, 0.f, 0.f}, 0, 0, 0);
                acc = __builtin_amdgcn_mfma_f32_16x16x32_bf16(a1, qf[h][1], acc, 0, 0, 0);
                const float w = h < 4 ? w0[h & 3] : w1[h & 3];
#pragma unroll
                for (int j = 0; j < 4; ++j) sc[j] += w * fmaxf(acc[j], 0.f);
            }
            u32x4 kv;
#pragma unroll
            for (int j = 0; j < 4; ++j) { float x = sc[j]; if (x == 0.f) x = 0.f; kv[j] = (kt * 16 + 4 * fq + j <= t) ? okey(x) : 0u; }
            *(IDX_LAS u32x4*)(panel + fr * PP + kt * 16 + 4 * fq) = kv;
        }
    }
    __syncthreads();
#pragma unroll 1
    for (int rr = 0; rr < 2; ++rr) {
        const int row = 2 * wid + rr, tq = q0 + row, n = tq + 1;
        unsigned v[32];
#pragma unroll
        for (int i = 0; i < 32; ++i) { const unsigned x = panel[row * PP + 64 * i + lane]; v[i] = (64 * i + lane <= tq) ? x : 0u; }
        unsigned T = 1u;
        if (n > 256) {
            T = 0u; bool done = false;
#pragma unroll 1
            for (int bit = 31; bit >= 0 && !done; --bit) {
                const unsigned cand = T | (1u << bit); int c = 0;
#pragma unroll
                for (int i = 0; i < 32; ++i) c += __builtin_popcountll(__ballot(v[i] >= cand));
                if (c >= 256) T = cand;
                if (c == 256) done = true;
            }
            if (!done) {
                int cgt = 0;
#pragma unroll
                for (int i = 0; i < 32; ++i) cgt += __builtin_popcountll(__ballot(v[i] > T));
                int need = 256 - cgt;
#pragma unroll
                for (int i = 0; i < 32; ++i) {
                    unsigned long long eq = __ballot(v[i] == T); const int c = __builtin_popcountll(eq);
                    if (c <= need) need -= c;
                    else { unsigned long long keep = eq; int k = c; while (k > need) { keep &= ~(1ull << (63 - __builtin_clzll(keep))); --k; }
                           const unsigned long long drop = eq & ~keep; if ((drop >> lane) & 1ull) v[i] = 0u; need = 0; }
                }
            }
        }
        unsigned long long mine = 0ull;
#pragma unroll
        for (int i = 0; i < 32; ++i) { const unsigned long long bal = __ballot(v[i] >= T); if (lane == i) mine = bal; }
        if (lane < 32) ((unsigned long long*)MASK)[(rowbase + tq) * 32 + lane] = mine;
    }
    __syncthreads();
}
}


namespace hg_body {
typedef short bf16x8 __attribute__((ext_vector_type(8)));
typedef float f32x4 __attribute__((ext_vector_type(4)));
typedef unsigned u32x4 __attribute__((ext_vector_type(4)));
#define HG_LAS __attribute__((address_space(3)))
constexpr int LB_OFF = 0, LBP = 132;
constexpr int QH_OFF = 33792, KH_OFF = 51200, QKP = 136;
constexpr int AB_OFF = 68608, ABP = 72;
constexpr int VT_OFF = 77824, VTP = 72;
constexpr int TOT_OFF = 96256;
constexpr int PRE_LDS_BYTES = TOT_OFF + 2048;
constexpr int STP = 136;
constexpr int SCAN_LDS_BYTES = 2 * 16 * STP * 2;

__device__ __forceinline__ void pre_unit(int b, int c, int h, const bf16_t* __restrict__ CAT, const float* __restrict__ LOGF, const bf16_t* __restrict__ HV,
                                         bf16_t* __restrict__ QT, bf16_t* __restrict__ KTt, bf16_t* __restrict__ VTt, float* __restrict__ G, float* __restrict__ OI, HG_LAS unsigned char* L) {
    const int tid = threadIdx.x, lane = tid & 63, wid = __builtin_amdgcn_readfirstlane(tid >> 6), fr = lane & 15, fq = lane >> 4;
    const int tile = (b * 32 + c) * 4 + h; const size_t row0 = (size_t)b * SEQ + c * 64;
    HG_LAS float* LB = (HG_LAS float*)(L + LB_OFF); HG_LAS bf16_t* QH = (HG_LAS bf16_t*)(L + QH_OFF); HG_LAS bf16_t* KH = (HG_LAS bf16_t*)(L + KH_OFF);
    HG_LAS bf16_t* AB = (HG_LAS bf16_t*)(L + AB_OFF); HG_LAS bf16_t* VT = (HG_LAS bf16_t*)(L + VT_OFF); HG_LAS float* TOT = (HG_LAS float*)(L + TOT_OFF);
    { const float* src = LOGF + (row0 + (tid >> 5)) * 512 + h * 128 + (tid & 31) * 4; HG_LAS float* dst = LB + (tid >> 5) * LBP + (tid & 31) * 4;
#pragma unroll
      for (int i = 0; i < 4; ++i) *(HG_LAS f32x4*)(dst + i * 16 * LBP) = *(const f32x4*)(src + (size_t)i * 16 * 512);
      const bf16_t* vsrc = HV + (row0 + (tid >> 4)) * 512 + h * 128 + (tid & 15) * 8;
#pragma unroll
      for (int i = 0; i < 2; ++i) { const bf16x8 vv = *(const bf16x8*)(vsrc + (size_t)i * 32 * 512); const int sidx = i * 32 + (tid >> 4);
#pragma unroll
          for (int e = 0; e < 8; ++e) VT[((tid & 15) * 8 + e) * VTP + sidx] = (bf16_t)vv[e]; } }
    __syncthreads();
    const int k = tid & 127, part = tid >> 7;
    float lf[16], bb[16];
    { float run = 0.f;
#pragma unroll
      for (int i = 0; i < 16; ++i) { lf[i] = LB[(16 * part + i) * LBP + k]; run += lf[i]; bb[i] = run; }
      TOT[part * 128 + k] = run; }
    __syncthreads();
    const float t0 = TOT[k], t1 = TOT[128 + k], t2 = TOT[256 + k], t3 = TOT[384 + k];
    const float off = part == 0 ? 0.f : part == 1 ? t0 : part == 2 ? t0 + t1 : (t0 + t1) + t2;
    const float b_mid = t0 + t1, b_last = (t0 + t1) + (t2 + t3);
    { const bf16_t* qsrc = CAT + (row0 + 16 * part) * 1024 + 512 + h * 128 + k; bf16_t* qdst = QT + (row0 + 16 * part) * 512 + h * 128 + k;
      unsigned kt16[8];
#pragma unroll
      for (int i = 0; i < 16; ++i) {
          const float eb = bb[i] + off, q = bf2f(qsrc[(size_t)i * 1024]), kk = 1.f - __expf(lf[i]);
          qdst[(size_t)i * 512] = f2bf(q * __expf(eb));
          QH[(16 * part + i) * QKP + k] = f2bf(q * __expf(fminf(eb - b_mid, 80.f)));
          KH[(16 * part + i) * QKP + k] = f2bf(kk * __expf(fminf(b_mid - eb, 80.f)));
          const unsigned kt = f2bf(kk * __expf(b_last - eb));
          if (i & 1) kt16[i >> 1] |= kt << 16; else kt16[i >> 1] = kt;
      }
      u32x4* kd = (u32x4*)(KTt + (size_t)tile * 8192 + k * 64 + 16 * part);
      kd[0] = (u32x4){kt16[0], kt16[1], kt16[2], kt16[3]}; kd[1] = (u32x4){kt16[4], kt16[5], kt16[6], kt16[7]};
      if (part == 0) G[tile * 128 + k] = __expf(b_last); }
    __syncthreads();
    { const int ti = wid >> 1;
#pragma unroll
      for (int jj = 0; jj < 2; ++jj) { const int tj = 2 * (wid & 1) + jj;
          f32x4 acc = (f32x4){0.f, 0.f, 0.f, 0.f};
          if (tj <= ti) {
#pragma unroll
              for (int ks = 0; ks < 4; ++ks) { const bf16x8 a = *(const HG_LAS bf16x8*)(QH + (16 * ti + fr) * QKP + 32 * ks + 8 * fq), bv = *(const HG_LAS bf16x8*)(KH + (16 * tj + fr) * QKP + 32 * ks + 8 * fq);
                  acc = __builtin_amdgcn_mfma_f32_16x16x32_bf16(a, bv, acc, 0, 0, 0); } }
#pragma unroll
          for (int j = 0; j < 4; ++j) { const int t = 16 * ti + 4 * fq + j, sx = 16 * tj + fr; AB[t * ABP + sx] = f2bf(sx <= t ? acc[j] : 0.f); } } }
    __syncthreads();
    {
#pragma unroll
      for (int ti = 0; ti < 4; ++ti) { f32x4 acc = (f32x4){0.f, 0.f, 0.f, 0.f};
#pragma unroll
          for (int ks = 0; ks < 2; ++ks) { const bf16x8 a = *(const HG_LAS bf16x8*)(AB + (16 * ti + fr) * ABP + 32 * ks + 8 * fq), bv = *(const HG_LAS bf16x8*)(VT + (16 * wid + fr) * VTP + 32 * ks + 8 * fq);
              acc = __builtin_amdgcn_mfma_f32_16x16x32_bf16(a, bv, acc, 0, 0, 0); }
#pragma unroll
          for (int j = 0; j < 4; ++j) OI[(row0 + 16 * ti + 4 * fq + j) * 512 + h * 128 + 16 * wid + fr] = acc[j]; }
#pragma unroll
      for (int i = 0; i < 2; ++i) { const int idx = i * 512 + tid, v = idx >> 3, ch = idx & 7; *(u32x4*)(VTt + (size_t)tile * 8192 + v * 64 + 8 * ch) = *(const HG_LAS u32x4*)(VT + v * VTP + 8 * ch); } }
    __syncthreads();
}

struct ScanRegs { bf16x8 qa[4]; f32x4 oi; bf16x8 ka[2]; bf16x8 vb[2]; f32x4 g; };
__device__ __forceinline__ void scan_load(ScanRegs& R, int b, int c, int h, int vs, int wid, int fr, int fq, const bf16_t* __restrict__ QT, const bf16_t* __restrict__ KTt, const bf16_t* __restrict__ VTt,
                                          const float* __restrict__ G, const float* OI) {
    const int tile = (b * 32 + c) * 4 + h; const size_t row0 = (size_t)b * SEQ + c * 64;
    if (wid < 4) {
#pragma unroll
        for (int ks = 0; ks < 4; ++ks) R.qa[ks] = *(const bf16x8*)(QT + (row0 + 16 * wid + fr) * 512 + h * 128 + 32 * ks + 8 * fq);
#pragma unroll
        for (int j = 0; j < 4; ++j) R.oi[j] = OI[(row0 + 16 * wid + 4 * fq + j) * 512 + h * 128 + 16 * vs + fr];
    }
#pragma unroll
    for (int ks = 0; ks < 2; ++ks) { R.ka[ks] = *(const bf16x8*)(KTt + (size_t)tile * 8192 + (16 * wid + fr) * 64 + 32 * ks + 8 * fq);
                                     R.vb[ks] = *(const bf16x8*)(VTt + (size_t)tile * 8192 + (16 * vs + fr) * 64 + 32 * ks + 8 * fq); }
    R.g = *(const f32x4*)(G + tile * 128 + 16 * wid + 4 * fq);
}
__device__ __forceinline__ void scan_step(const ScanRegs& R, f32x4& S, int b, int c, int h, int vs, int wid, int fr, int fq, float* O, HG_LAS bf16_t* ST) {
    HG_LAS bf16_t* st = ST + (c & 1) * 16 * STP;
    { typedef unsigned u32x2_t __attribute__((ext_vector_type(2))); u32x2_t w; w.x = (unsigned)f2bf(S[0]) | ((unsigned)f2bf(S[1]) << 16); w.y = (unsigned)f2bf(S[2]) | ((unsigned)f2bf(S[3]) << 16); *(HG_LAS u32x2_t*)(st + fr * STP + 16 * wid + 4 * fq) = w; }
    __syncthreads();
    if (wid < 4) {
        f32x4 acc = R.oi;
#pragma unroll
        for (int ks = 0; ks < 4; ++ks) { const bf16x8 bv = *(const HG_LAS bf16x8*)(st + fr * STP + 32 * ks + 8 * fq); acc = __builtin_amdgcn_mfma_f32_16x16x32_bf16(R.qa[ks], bv, acc, 0, 0, 0); }
        const size_t row0 = (size_t)b * SEQ + c * 64;
#pragma unroll
        for (int j = 0; j < 4; ++j) O[(row0 + 16 * wid + 4 * fq + j) * 512 + h * 128 + 16 * vs + fr] = acc[j];
    }
    S = S * R.g;
    S = __builtin_amdgcn_mfma_f32_16x16x32_bf16(R.ka[0], R.vb[0], S, 0, 0, 0);
    S = __builtin_amdgcn_mfma_f32_16x16x32_bf16(R.ka[1], R.vb[1], S, 0, 0, 0);
}
__device__ __forceinline__ void scan_unit(int b, int h, int vs, const bf16_t* __restrict__ QT, const bf16_t* __restrict__ KTt, const bf16_t* __restrict__ VTt, const float* __restrict__ G, float* O, HG_LAS unsigned char* L) {
    const int tid = threadIdx.x, lane = tid & 63, wid = __builtin_amdgcn_readfirstlane(tid >> 6), fr = lane & 15, fq = lane >> 4;
    HG_LAS bf16_t* ST = (HG_LAS bf16_t*)L;
    f32x4 S = (f32x4){0.f, 0.f, 0.f, 0.f};
    ScanRegs Ra, Rb;
    scan_load(Ra, b, 0, h, vs, wid, fr, fq, QT, KTt, VTt, G, O);
#pragma unroll 1
    for (int c = 0; c < 32; c += 2) {
        scan_load(Rb, b, c + 1, h, vs, wid, fr, fq, QT, KTt, VTt, G, O);
        scan_step(Ra, S, b, c, h, vs, wid, fr, fq, O, ST);
        if (c + 2 < 32) scan_load(Ra, b, c + 2, h, vs, wid, fr, fq, QT, KTt, VTt, G, O);
        scan_step(Rb, S, b, c + 1, h, vs, wid, fr, fq, O, ST);
    }
    __syncthreads();
}
__device__ __forceinline__ void norm_row(size_t row, int lane, const float* __restrict__ O, const bf16_t* __restrict__ HG, const float* __restrict__ gain, bf16_t* __restrict__ CAT) {
    const f32x4 o0 = *(const f32x4*)(O + row * 512 + 8 * lane), o1 = *(const f32x4*)(O + row * 512 + 8 * lane + 4);
    float ss = (o0[0] * o0[0] + o0[1] * o0[1]) + (o0[2] * o0[2] + o0[3] * o0[3]) + (o1[0] * o1[0] + o1[1] * o1[1]) + (o1[2] * o1[2] + o1[3] * o1[3]);
    ss += __shfl_xor(ss, 1); ss += __shfl_xor(ss, 2); ss += __shfl_xor(ss, 4); ss += __shfl_xor(ss, 8);
    const float r = rsqrtf(ss * (1.f / 128.f) + EPS);
    const f32x4 g0 = *(const f32x4*)(gain + 8 * lane), g1 = *(const f32x4*)(gain + 8 * lane + 4);
    const u32x4 hg = *(const u32x4*)(HG + row * 512 + 8 * lane);
    u32x4 w;
    w.x = (unsigned)f2bf(o0[0] * r * g0[0] * bf2f((bf16_t)(hg.x & 0xffffu))) | ((unsigned)f2bf(o0[1] * r * g0[1] * bf2f((bf16_t)(hg.x >> 16))) << 16);
    w.y = (unsigned)f2bf(o0[2] * r * g0[2] * bf2f((bf16_t)(hg.y & 0xffffu))) | ((unsigned)f2bf(o0[3] * r * g0[3] * bf2f((bf16_t)(hg.y >> 16))) << 16);
    w.z = (unsigned)f2bf(o1[0] * r * g1[0] * bf2f((bf16_t)(hg.z & 0xffffu))) | ((unsigned)f2bf(o1[1] * r * g1[1] * bf2f((bf16_t)(hg.z >> 16))) << 16);
    w.w = (unsigned)f2bf(o1[2] * r * g1[2] * bf2f((bf16_t)(hg.w & 0xffffu))) | ((unsigned)f2bf(o1[3] * r * g1[3] * bf2f((bf16_t)(hg.w >> 16))) << 16);
    *(u32x4*)(CAT + row * 1024 + 512 + 8 * lane) = w;
}
}


namespace row_body {
typedef float f32x4 __attribute__((ext_vector_type(4)));
typedef unsigned u32x4 __attribute__((ext_vector_type(4)));
typedef unsigned u32x2 __attribute__((ext_vector_type(2)));
#define RB_LAS __attribute__((address_space(3)))
__device__ __forceinline__ float wave_sum(float v) {
#pragma unroll
    for (int o = 1; o < 64; o <<= 1) v += __shfl_xor(v, o);
    return v;
}
__device__ __forceinline__ unsigned pk2(float lo, float hi) { return (unsigned)f2bf(lo) | ((unsigned)f2bf(hi) << 16); }
template <class CM> __device__ __forceinline__ void transpose_item(int K, int N, bf16_t* WT, RB_LAS float* scr, int item, int lane, const CM& cm) {
    const int nblk = N / 32, kb = item / nblk, nb = item % nblk, k0 = 64 * kb, n0 = 32 * nb;
    int ncols; const float* base; const int col = cm(n0 + (lane & 31), base, ncols);
    const float* src = base + (size_t)(k0 + (lane >> 5)) * ncols + (col >= 0 ? col : 0);
#pragma unroll 8
    for (int i = 0; i < 32; ++i) { const int kk = 2 * i + (lane >> 5); scr[kk * 33 + (lane & 31)] = col >= 0 ? src[(size_t)(2 * i) * ncols] : 0.f; }
    asm volatile("s_waitcnt lgkmcnt(0)" ::: "memory");
    const int c = lane & 7;
#pragma unroll
    for (int j = 0; j < 4; ++j) { const int n = (lane >> 3) + 8 * j; const RB_LAS float* sp = scr + (8 * c) * 33 + n;
        u32x4 o; o.x = pk2(sp[0 * 33], sp[1 * 33]); o.y = pk2(sp[2 * 33], sp[3 * 33]); o.z = pk2(sp[4 * 33], sp[5 * 33]); o.w = pk2(sp[6 * 33], sp[7 * 33]);
        *(u32x4*)(WT + (size_t)(n0 + n) * K + k0 + 8 * c) = o; }
    asm volatile("s_waitcnt lgkmcnt(0)" ::: "memory");
}
struct CmW1 { const float* w; __device__ __forceinline__ int operator()(int n, const float*& base, int& ncols) const { base = w; ncols = NIN; return w1_src_col(n); } };
struct CmId { const float* w; int n_; __device__ __forceinline__ int operator()(int n, const float*& base, int& ncols) const { base = w; ncols = n_; return n; } };
struct CmGU { const float* wg; const float* wu; __device__ __forceinline__ int operator()(int n, const float*& base, int& ncols) const { const int t = n >> 8, w = n & 255; ncols = DFF;
    const unsigned long long a = (unsigned long long)wg, d = (unsigned long long)wu - a; base = (const float*)(a + (unsigned long long)(w >> 7) * d); return t * 128 + (w & 127); } };
__device__ __forceinline__ void rms_row_bf16(const float* xrow, const float* g, bf16_t* orow, int lane) {
    const f32x4* xr = (const f32x4*)xrow + lane; f32x4 v[4]; float ss = 0.f;
#pragma unroll
    for (int j = 0; j < 4; ++j) { v[j] = xr[64 * j]; ss += (v[j][0] * v[j][0] + v[j][1] * v[j][1]) + (v[j][2] * v[j][2] + v[j][3] * v[j][3]); }
    const float r = rsqrtf(wave_sum(ss) * (1.f / DM) + EPS);
    u32x2* o8 = (u32x2*)orow + lane;
#pragma unroll
    for (int j = 0; j < 4; ++j) { const f32x4 gg = ((const f32x4*)g)[lane + 64 * j]; u32x2 w; w.x = pk2(v[j][0] * r * gg[0], v[j][1] * r * gg[1]); w.y = pk2(v[j][2] * r * gg[2], v[j][3] * r * gg[3]); o8[64 * j] = w; }
}
__device__ __forceinline__ void postmix_row(const float* mix, const float* xrow, const float* g1, const float* g2, float* orow, bf16_t* hrow, int lane) {
    f32x4 m[4]; float ss = 0.f;
#pragma unroll
    for (int j = 0; j < 4; ++j) { m[j] = ((const f32x4*)mix)[lane + 64 * j]; ss += (m[j][0] * m[j][0] + m[j][1] * m[j][1]) + (m[j][2] * m[j][2] + m[j][3] * m[j][3]); }
    const float r1 = rsqrtf(wave_sum(ss) * (1.f / DM) + EPS); float s2 = 0.f;
#pragma unroll
    for (int j = 0; j < 4; ++j) { const f32x4 xv = ((const f32x4*)xrow)[lane + 64 * j], a = ((const f32x4*)g1)[lane + 64 * j]; m[j] = xv + m[j] * r1 * a; ((f32x4*)orow)[lane + 64 * j] = m[j];
        s2 += (m[j][0] * m[j][0] + m[j][1] * m[j][1]) + (m[j][2] * m[j][2] + m[j][3] * m[j][3]); }
    const float r2 = rsqrtf(wave_sum(s2) * (1.f / DM) + EPS);
    u32x2* o8 = (u32x2*)hrow + lane;
#pragma unroll
    for (int j = 0; j < 4; ++j) { const f32x4 c = ((const f32x4*)g2)[lane + 64 * j]; u32x2 w; w.x = pk2(m[j][0] * r2 * c[0], m[j][1] * r2 * c[1]); w.y = pk2(m[j][2] * r2 * c[2], m[j][3] * r2 * c[3]); o8[64 * j] = w; }
}
__device__ __forceinline__ void final_row(const float* raw, const float* g, float* orow, int lane) {
    f32x4 m[4]; float ss = 0.f;
#pragma unroll
    for (int j = 0; j < 4; ++j) { m[j] = ((const f32x4*)raw)[lane + 64 * j]; ss += (m[j][0] * m[j][0] + m[j][1] * m[j][1]) + (m[j][2] * m[j][2] + m[j][3] * m[j][3]); }
    const float r = rsqrtf(wave_sum(ss) * (1.f / DM) + EPS);
#pragma unroll
    for (int j = 0; j < 4; ++j) { const f32x4 gg = ((const f32x4*)g)[lane + 64 * j]; ((f32x4*)orow)[lane + 64 * j] = ((const f32x4*)orow)[lane + 64 * j] + m[j] * r * gg; }
}
__device__ __forceinline__ void tables(int i, float* rope, float* lb, const float* lbp) {
    if (i < 2048 * 8) {
        const int pos = i >> 3, j = i & 7;
        const float inv = powf(500000.0f, -(float)j / 8.0f);
        const float ang = (float)pos * inv;
        const double a = (double)ang, twopi = 6.283185307179586476925;
        const double n = rint(a / twopi), r = a - n * twopi;
        double sn, cs; sincos_taylor(r, sn, cs);
        rope[2 * i] = (float)cs; rope[2 * i + 1] = (float)sn;
    }
    if (i < 512) { const float a = lbp[i], b = lbp[512 + i]; const float m = fmaxf(a, b); const float ea = expf(a - m), eb = expf(b - m); lb[i] = ea / (ea + eb); }
}
}

constexpr int NWAVES = 8;
constexpr int RING_OFF = 0, RING_BYTES = 131072;
constexpr int LDSCTL_OFF = 155648, MISC_OFF = LDSCTL_OFF + 320;
constexpr int LDS_BYTES = 163840;
static_assert(hg_body::PRE_LDS_BYTES <= LDSCTL_OFF && hg_body::SCAN_LDS_BYTES <= LDSCTL_OFF, "hgrn scratch vs LDS control words");
static_assert(idx_body::IDX_LDS_BYTES <= LDSCTL_OFF, "indexer panel vs LDS control words");
static_assert(attn_body::ATTN_LDS_BYTES <= LDSCTL_OFF, "attention scratch vs LDS control words");
constexpr int CW_BAR = 4096;
#define GAS __attribute__((address_space(1)))
#define LAS __attribute__((address_space(3)))
typedef unsigned v4u __attribute__((ext_vector_type(4)));
typedef float f32x4 __attribute__((ext_vector_type(4)));
typedef short bf16x8 __attribute__((ext_vector_type(8)));
typedef GAS unsigned gu32;
typedef GAS unsigned long long gu64;
#define RLX_AGENT __ATOMIC_RELAXED, __HIP_MEMORY_SCOPE_AGENT
#define LDS_WAIT() asm volatile("s_waitcnt lgkmcnt(0)" ::: "memory")
#define VM_WAIT() asm volatile("s_waitcnt vmcnt(0)" ::: "memory")
__device__ __forceinline__ unsigned long long rt() { return __builtin_amdgcn_s_memrealtime(); }
__device__ __forceinline__ unsigned pk2(float lo, float hi) { return (unsigned)f2bf(lo) | ((unsigned)f2bf(hi) << 16); }

#define XB_TMO      128
#define XB_XCNT(j)  (256  + 64 * (j))
#define XB_XSUB(j)  (1280 + 64 * (j))
#define XB_XGEN(j)  (2304 + 64 * (j))
#define XB_TOP      3328
#define XB_TOPGEN   3392
#define XCD_BAR_WORDS 3456
#define XB_SPIN_CAP (1u << 18)

__device__ __forceinline__ unsigned xb_ld(unsigned* p)              { return __hip_atomic_load(p, __ATOMIC_RELAXED, __HIP_MEMORY_SCOPE_AGENT); }
__device__ __forceinline__ unsigned xb_add(unsigned* p, unsigned v) { return __hip_atomic_fetch_add(p, v, __ATOMIC_RELAXED, __HIP_MEMORY_SCOPE_AGENT); }
__device__ __forceinline__ unsigned xb_xcc_id() { return (unsigned)__builtin_amdgcn_s_getreg((3 << 11) | 20) & 0xFu; }
#define XB_SPIN(cond, bar) do { unsigned _sp = 0; while (cond) { __builtin_amdgcn_s_sleep(1); \
    if ((++_sp & 255u) == 0u) { if (xb_ld(&(bar)[XB_TMO])) break; if (_sp > XB_SPIN_CAP) { atomicAdd(&(bar)[XB_TMO], 1u); break; } } } } while (0)

struct XcdBarrier {
    unsigned* bar; unsigned x;
    volatile LAS unsigned* st;
};

__device__ __forceinline__ XcdBarrier xcd_barrier_post(unsigned* bar, volatile LAS unsigned* st) {
    XcdBarrier b; b.bar = bar; b.x = xb_xcc_id(); b.st = st;
    if (threadIdx.x == 0) (void)xb_add(&bar[XB_XCNT(b.x)], 1u);
    return b;
}
__device__ __forceinline__ void xcd_barrier_complete(unsigned* bar, unsigned x, unsigned& nloc, unsigned& nx) {
    const unsigned G = gridDim.x * gridDim.y * gridDim.z;
    unsigned sum, cnt, mine, sp = 0u;
    for (;;) {
        sum = 0u; cnt = 0u; mine = 0u;
#pragma unroll
        for (unsigned j = 0; j < 16; ++j) { const unsigned c = xb_ld(&bar[XB_XCNT(j)]); sum += c; cnt += (c > 0u) ? 1u : 0u; mine = (j == x) ? c : mine; }
        if (sum == G) break;
        __builtin_amdgcn_s_sleep(1);
        if ((++sp & 255u) == 0u) { if (xb_ld(&bar[XB_TMO])) break; if (sp > XB_SPIN_CAP) { atomicAdd(&bar[XB_TMO], 1u); break; } }
    }
    nloc = mine > 0u ? mine : 1u; nx = cnt > 0u ? cnt : 1u;
}

__device__ __forceinline__ void xcd_barrier(const XcdBarrier& b) {
    asm volatile("s_waitcnt vmcnt(0)" ::: "memory");
    __syncthreads();
    if (threadIdx.x == 0) {
        unsigned* bar = b.bar;
        __builtin_amdgcn_s_waitcnt(0);
        unsigned nloc = b.st[0], nx = b.st[1];
        if (nloc == 0u) { xcd_barrier_complete(bar, b.x, nloc, nx); b.st[0] = nloc; b.st[1] = nx; }
        const unsigned old = xb_add(&bar[XB_XSUB(b.x)], 1u);
        const unsigned gen = old / nloc;
        if (old + 1u == (gen + 1u) * nloc) {
            __builtin_amdgcn_fence(__ATOMIC_RELEASE, "agent");
            asm volatile("s_waitcnt vmcnt(0)" ::: "memory");
            const unsigned og = xb_add(&bar[XB_TOP], 1u);
            const unsigned tg = og / nx;
            if (og + 1u == (tg + 1u) * nx) xb_add(&bar[XB_TOPGEN], 1u);
            else XB_SPIN(xb_ld(&bar[XB_TOPGEN]) == tg, bar);
            __builtin_amdgcn_fence(__ATOMIC_ACQUIRE, "agent");
            xb_add(&bar[XB_XGEN(b.x)], 1u);
            asm volatile("s_waitcnt vmcnt(0)" ::: "memory");
        } else {
            XB_SPIN(xb_ld(&bar[XB_XGEN(b.x)]) == gen, bar);
            __builtin_amdgcn_fence(__ATOMIC_ACQUIRE, "agent");
            asm volatile("s_waitcnt vmcnt(0)" ::: "memory");
        }
    }
    __syncthreads();
}

struct Args { const float* in[12]; float* out; unsigned char* ws; int ph_lo, ph_hi; };
__global__ void __launch_bounds__(NWAVES * 64, 2) mk_fwd(Args args) {
    extern __shared__ __attribute__((aligned(16))) unsigned char lds[];
    LAS unsigned char* L = (LAS unsigned char*)lds;
    const int tid = threadIdx.x;
    const int G = gridDim.x;
    unsigned char* ws = args.ws;
    gu32* ctl = (gu32*)(ws + WS_CTL);
    for (int u = tid; u < (LDS_BYTES - LDSCTL_OFF) / 4; u += NWAVES * 64) ((LAS unsigned*)(L + LDSCTL_OFF))[u] = 0u;
    __syncthreads();
    volatile LAS unsigned* MISC = (volatile LAS unsigned*)(L + MISC_OFF);
    const int lo = args.ph_lo, hi = args.ph_hi;
    XcdBarrier bar; bar.bar = (unsigned*)(ctl + CW_BAR); bar.x = 0; bar.st = nullptr;
    if (hi - lo > 1) bar = xcd_barrier_post((unsigned*)(ctl + CW_BAR), MISC + 8);
#define IN(k) (lo <= (k) && (k) < hi)
#define BOTH(k) (IN(k) && IN((k) + 1))
    float* rope = (float*)(ws + WS_TAB); float* lb = rope + 2048 * 16;
    bf16_t* W1t = (bf16_t*)(ws + WS_W1); bf16_t* Wot = (bf16_t*)(ws + WS_WO); bf16_t* Wgut = (bf16_t*)(ws + WS_WGU); bf16_t* Wdt = (bf16_t*)(ws + WS_WD);
    bf16_t* XN = (bf16_t*)(ws + WS_XN); bf16_t* CAT = (bf16_t*)(ws + WS_CAT); bf16_t* Kb = (bf16_t*)(ws + WS_K); bf16_t* Vb = (bf16_t*)(ws + WS_V);
    bf16_t* QI = (bf16_t*)(ws + WS_QI); bf16_t* KI = (bf16_t*)(ws + WS_KI); float* WI = (float*)(ws + WS_WI); bf16_t* HV = (bf16_t*)(ws + WS_HV); bf16_t* HG = (bf16_t*)(ws + WS_HG);
    float* TMP = (float*)(ws + WS_TMP); bf16_t* FF = (bf16_t*)(ws + WS_FF);
    float* LOGF = args.out;

    const int vcu = (G % 8 == 0) ? ((int)blockIdx.x % 8) * (G / 8) + (int)blockIdx.x / 8 : (int)blockIdx.x;
    const int wv = __builtin_amdgcn_readfirstlane(tid >> 6);
    if (IN(0)) {
        row_body::tables(vcu * (NWAVES * 64) + tid, rope, lb, args.in[5]);
        RB_LAS float* scr = (RB_LAS float*)(L + RING_OFF + wv * 16384);
        const int gw = vcu * NWAVES + wv, NGW = G * NWAVES, lane = tid & 63;
        constexpr int I1 = (DM / 64) * (NINP / 32), IO = (DM / 64) * (DM / 32), IGU = (DM / 64) * (2 * DFF / 32), ID = (DFF / 64) * (DM / 32);
        for (int it = gw; it < I1 + IO + IGU + ID; it += NGW) {
            int r = it;
            if (r < I1) { row_body::transpose_item(DM, NINP, W1t, scr, r, lane, row_body::CmW1{args.in[2]}); continue; } r -= I1;
            if (r < IO) { row_body::transpose_item(DM, DM, Wot, scr, r, lane, row_body::CmId{args.in[3], DM}); continue; } r -= IO;
            if (r < IGU) { row_body::transpose_item(DM, 2 * DFF, Wgut, scr, r, lane, row_body::CmGU{args.in[8], args.in[9]}); continue; } r -= IGU;
            row_body::transpose_item(DFF, DM, Wdt, scr, r, lane, row_body::CmId{args.in[10], DM});
        }
        for (int row = gw; row < M; row += NGW) row_body::rms_row_bf16(args.in[0] + (size_t)row * DM, args.in[1], XN + (size_t)row * DM, lane);
        if (BOTH(0)) xcd_barrier(bar);
    }
    if (IN(1)) {
        pg8::Gemm g{XN, W1t, M, NINP, DM}; pg8::StaticOrder S; S.init(M, NINP, G, (int)blockIdx.x);
        pg8::EpiG1 E{CAT, Kb, Vb, QI, KI, HV, HG, WI, LOGF, rope, lb};
        pg8::gemm_phase<pg8::EpiG1, pg8::StaticOrder, true, true>(L + RING_OFF, g, S, E);
        if (BOTH(1)) xcd_barrier(bar);
    }
    if (IN(2)) {
        IDX_LAS unsigned* panel = (IDX_LAS unsigned*)(L + RING_OFF);
        for (int p = vcu; p < 512; p += G) { const int b = p >> 6, sidx = p & 63;
            idx_body::idx_unit(b, sidx, QI, KI, WI, (unsigned*)(ws + WS_MASK), panel);
            idx_body::idx_unit(b, 127 - sidx, QI, KI, WI, (unsigned*)(ws + WS_MASK), panel); }
        { bf16_t* QT = (bf16_t*)(ws + WS_QT); bf16_t* KTt = (bf16_t*)(ws + WS_KT); bf16_t* VTt = (bf16_t*)(ws + WS_VT); float* Gg = (float*)(ws + WS_G); float* OI = args.out + (size_t)M * 512;
          for (int u = vcu; u < 1024; u += G) hg_body::pre_unit(u >> 7, (u >> 2) & 31, u & 3, CAT, LOGF, HV, QT, KTt, VTt, Gg, OI, L + RING_OFF); }
        if (BOTH(2)) xcd_barrier(bar);
    }
    if (IN(3)) {
        { const bf16_t* QT = (const bf16_t*)(ws + WS_QT); const bf16_t* KTt = (const bf16_t*)(ws + WS_KT); const bf16_t* VTt = (const bf16_t*)(ws + WS_VT); const float* Gg = (const float*)(ws + WS_G); float* O = args.out + (size_t)M * 512;
          for (int u = vcu; u < 256; u += G) hg_body::scan_unit(u >> 5, (u >> 3) & 3, u & 7, QT, KTt, VTt, Gg, O, L + RING_OFF); }
        {
        const attn_body::AttnTensors AT{CAT, Kb, Vb, CAT, (const unsigned*)(ws + WS_MASK)};
        const attn_body::StaticOrder S(G, (int)blockIdx.x);
        attn_body::attn_phase<attn_body::StaticOrder>((char*)lds + RING_OFF, AT, S); }
        if (BOTH(3)) xcd_barrier(bar);
    }
    if (IN(4)) {
        const float* O = args.out + (size_t)M * 512;
        for (int row = vcu * NWAVES + wv; row < M; row += G * NWAVES) hg_body::norm_row((size_t)row, tid & 63, O, HG, args.in[6], CAT);
        if (BOTH(4)) xcd_barrier(bar);
    }
    if (IN(5)) {
        pg8::Gemm g{CAT, Wot, M, DM, DM}; pg8::StaticOrder S; S.init(M, DM, G, (int)blockIdx.x);
        pg8::EpiF32 E{TMP, DM};
        pg8::gemm_phase<pg8::EpiF32, pg8::StaticOrder, true, true>(L + RING_OFF, g, S, E);
        if (BOTH(5)) xcd_barrier(bar);
    }
    if (IN(6)) {
        for (int row = vcu * NWAVES + wv; row < M; row += G * NWAVES)
            row_body::postmix_row(TMP + (size_t)row * DM, args.in[0] + (size_t)row * DM, args.in[4], args.in[7], args.out + (size_t)row * DM, XN + (size_t)row * DM, tid & 63);
        if (BOTH(6)) xcd_barrier(bar);
    }
    if (IN(7)) {
        pg8::Gemm g{XN, Wgut, M, 2 * DFF, DM}; pg8::StaticOrder S; S.init(M, 2 * DFF, G, (int)blockIdx.x);
        pg8::EpiSwigluMk E{FF};
        pg8::gemm_phase<pg8::EpiSwigluMk, pg8::StaticOrder, true, true>(L + RING_OFF, g, S, E);
        if (BOTH(7)) xcd_barrier(bar);
    }
    if (IN(8)) {
        pg8::Gemm g{FF, Wdt, M, DM, DFF}; pg8::StaticOrder S; S.init(M, DM, G, (int)blockIdx.x);
        pg8::EpiF32 E{TMP, DM};
        pg8::gemm_phase<pg8::EpiF32, pg8::StaticOrder, true, true>(L + RING_OFF, g, S, E);
        if (BOTH(8)) xcd_barrier(bar);
    }
    if (IN(9)) {
        for (int row = vcu * NWAVES + wv; row < M; row += G * NWAVES) row_body::final_row(TMP + (size_t)row * DM, args.in[11], args.out + (size_t)row * DM, tid & 63);
    }
#undef IN
#undef BOTH
}

static void launch_mk(Args a, int lo, int hi, int grid, hipStream_t stream) {
    a.ph_lo = lo; a.ph_hi = hi;
    hipLaunchKernelGGL(mk_fwd, dim3(grid), dim3(NWAVES * 64), LDS_BYTES, stream, a);
}
extern "C" void kernel_launch(void* const* d_in, const int* in_sizes, int n_in, void* d_out, int out_size, void* d_ws, size_t ws_size, hipStream_t stream) {
    if (n_in != 12 || ws_size < WS_END) { fprintf(stderr, "kernel_launch: unexpected inputs (%d) or workspace (%zu)\n", n_in, ws_size); return; }
    static int grid = 0;
    if (grid == 0) {
        int dev = 0, cus = 0;
        if (hipGetDevice(&dev) != hipSuccess || hipDeviceGetAttribute(&cus, hipDeviceAttributeMultiprocessorCount, dev) != hipSuccess) { grid = -1; return; }
        if (hipFuncSetAttribute((const void*)mk_fwd, hipFuncAttributeMaxDynamicSharedMemorySize, LDS_BYTES) != hipSuccess) { fprintf(stderr, "hipFuncSetAttribute failed\n"); grid = -1; return; }
        grid = cus;
    }
    if (grid < 0) return;
    const float* x = (const float*)d_in[0]; const float* g_pre = (const float*)d_in[1]; const float* w_in = (const float*)d_in[2]; const float* w_out = (const float*)d_in[3];
    const float* g_post = (const float*)d_in[4]; const float* lbp = (const float*)d_in[5]; const float* g_hg = (const float*)d_in[6]; const float* g_pre_ffn = (const float*)d_in[7];
    const float* w_gate = (const float*)d_in[8]; const float* w_up = (const float*)d_in[9]; const float* w_down = (const float*)d_in[10]; const float* g_post_ffn = (const float*)d_in[11];
    unsigned char* ws = (unsigned char*)d_ws; float* out = (float*)d_out;
    float* rope = (float*)(ws + WS_TAB); float* lb = rope + 2048 * 16;
    bf16_t* W1t = (bf16_t*)(ws + WS_W1); bf16_t* Wot = (bf16_t*)(ws + WS_WO); bf16_t* Wgut = (bf16_t*)(ws + WS_WGU); bf16_t* Wdt = (bf16_t*)(ws + WS_WD);
    bf16_t* XN = (bf16_t*)(ws + WS_XN); bf16_t* CAT = (bf16_t*)(ws + WS_CAT); bf16_t* Kb = (bf16_t*)(ws + WS_K); bf16_t* Vb = (bf16_t*)(ws + WS_V);
    bf16_t* QI = (bf16_t*)(ws + WS_QI); bf16_t* KI = (bf16_t*)(ws + WS_KI); float* WI = (float*)(ws + WS_WI); bf16_t* HV = (bf16_t*)(ws + WS_HV); bf16_t* HG = (bf16_t*)(ws + WS_HG);
    unsigned* MASK = (unsigned*)(ws + WS_MASK); float* TMP = (float*)(ws + WS_TMP);
    float* LOGF = out; float* O = out + (size_t)M * 512;
    (void)hipMemsetAsync(ws + WS_CTL, 0, 1 * MiB, stream);
    Args a{}; for (int i = 0; i < 12; ++i) a.in[i] = (const float*)d_in[i]; a.out = out; a.ws = ws;

    launch_mk(a, 0, 10, grid, stream);
}
```
